# Optimizing an MI355X kernel written in HIP

```python
import math
import jax
import jax.numpy as jnp
from jax import lax
import numpy as np

D_MODEL = 1024
BATCH = 8
SEQ = 4096
DEPTH = 4

GRID_W = 64
CTX_LEN = 256
N_MIXERS = 2
WIDTH = D_MODEL
NA_HEADS = 16
NA_HEAD_DIM = WIDTH // NA_HEADS
NA_WIN_R = 8
NA_WIN_C = 16
DIFF_HEADS = 8
DIFF_HEAD_DIM = WIDTH // (2 * DIFF_HEADS)
Q_BLOCK = 128
ROPE_BASE = 10000.0
LN_EPS = 1e-5
DEEPNORM_ALPHA = (2.0 * DEPTH) ** 0.25
DEEPNORM_BETA = (8.0 * DEPTH) ** -0.25
N_NA_LAYERS = (DEPTH + 1) // 2
N_DIFF_LAYERS = DEPTH // 2

kernel_name = 'hybrid_natten_diffattn_dit'


def _layer_norm(x, g, b):
    xf = x.astype(jnp.float32)
    mu = jnp.mean(xf, axis=-1, keepdims=True)
    var = jnp.mean(jnp.square(xf - mu), axis=-1, keepdims=True)
    return ((xf - mu) * lax.rsqrt(var + LN_EPS)).astype(x.dtype) * g + b


def _rms_norm(x, g):
    xf = x.astype(jnp.float32)
    ms = jnp.mean(jnp.square(xf), axis=-1, keepdims=True)
    return (xf * lax.rsqrt(ms + LN_EPS)).astype(x.dtype) * g


def _modulation(cond, w_mod, b_mod):
    m = jax.nn.silu(cond) @ w_mod + b_mod
    return jnp.split(m, 3, axis=-1)


def _split_heads(t, n_heads):
    b, n, _ = t.shape
    return t.reshape(b, n, n_heads, -1).transpose(0, 2, 1, 3)


def _merge_heads(t):
    b, h, n, d = t.shape
    return t.transpose(0, 2, 1, 3).reshape(b, n, h * d)


def _softmax_attend(q, k, v, scale):
    s = jnp.einsum('bhqd,bhkd->bhqk', q, k).astype(jnp.float32) * scale
    p = jax.nn.softmax(s, axis=-1).astype(v.dtype)
    return jnp.einsum('bhqk,bhkd->bhqd', p, v)


def _axial_rope_tables(n_tok):
    t = jnp.arange(n_tok, dtype=jnp.int32)
    pos = jnp.stack([t // GRID_W, t % GRID_W], axis=-1).astype(jnp.float32)
    n_freq = DIFF_HEAD_DIM // 4
    inv_freq = ROPE_BASE ** (-jnp.arange(n_freq, dtype=jnp.float32) / n_freq)
    ang = pos[:, :, None] * inv_freq
    return jnp.cos(ang), jnp.sin(ang)


def _apply_axial_rope(x, cos, sin):
    shp = x.shape
    xr = x.reshape(shp[:-1] + (2, 2, shp[-1] // 4))
    x1, x2 = xr[..., 0, :], xr[..., 1, :]
    cos = cos.astype(x.dtype)
    sin = sin.astype(x.dtype)
    out = jnp.stack([x1 * cos - x2 * sin, x2 * cos + x1 * sin], axis=-2)
    return out.reshape(shp)


def _na_mixer(q, k, v, qc, kc, vc, rpb, need_ctx):
    q, k, v = _split_heads(q, NA_HEADS), _split_heads(k, NA_HEADS), _split_heads(v, NA_HEADS)
    kc, vc = _split_heads(kc, NA_HEADS), _split_heads(vc, NA_HEADS)
    b, h, n, d = q.shape
    rows = n // GRID_W
    kr = min(NA_WIN_R, rows)
    n_win = kr * NA_WIN_C
    scale = d ** -0.5
    kg = k.reshape(b, h, rows, GRID_W, d)
    vg = v.reshape(b, h, rows, GRID_W, d)
    q_rows = jnp.moveaxis(q.reshape(b, h, rows, GRID_W, d), 2, 0)
    r_idx = jnp.arange(rows, dtype=jnp.int32)
    row_start = jnp.clip(r_idx - kr // 2, 0, rows - kr)
    w_idx = jnp.arange(GRID_W, dtype=jnp.int32)
    col_start = jnp.clip(w_idx - NA_WIN_C // 2, 0, GRID_W - NA_WIN_C)
    col_idx = col_start[:, None] + jnp.arange(NA_WIN_C, dtype=jnp.int32)
    rpb_cols = rpb[:, :, col_idx - w_idx[:, None] + NA_WIN_C - 1]

    def row_block(args):
        q_r, r, r0 = args
        k_win = lax.dynamic_slice_in_dim(kg, r0, kr, axis=2)[:, :, :, col_idx, :]
        v_win = lax.dynamic_slice_in_dim(vg, r0, kr, axis=2)[:, :, :, col_idx, :]
        bias = rpb_cols[:, r0 + jnp.arange(kr, dtype=jnp.int32) - r + NA_WIN_R - 1]
        s_loc = (jnp.einsum('bhwd,bhiwjd->bhwij', q_r, k_win).astype(jnp.float32) * scale
                 + bias.transpose(0, 2, 1, 3).astype(jnp.float32))
        s_ctx = jnp.einsum('bhwd,bhcd->bhwc', q_r, kc).astype(jnp.float32) * scale
        s = jnp.concatenate([s_loc.reshape(b, h, GRID_W, n_win), s_ctx], axis=-1)
        p = jax.nn.softmax(s, axis=-1).astype(v.dtype)
        p_loc = p[..., :n_win].reshape(b, h, GRID_W, kr, NA_WIN_C)
        return (jnp.einsum('bhwij,bhiwjd->bhwd', p_loc, v_win)
                + jnp.einsum('bhwc,bhcd->bhwd', p[..., n_win:], vc))

    y = lax.map(row_block, (q_rows, r_idx, row_start))
    y = jnp.moveaxis(y, 0, 2).reshape(b, h, n, d)
    y_ctx = None
    if need_ctx:
        y_ctx = _merge_heads(_softmax_attend(_split_heads(qc, NA_HEADS), kc, vc, scale))
    return _merge_heads(y), y_ctx


def _diff_heads(t):
    b, n, _ = t.shape
    return t.reshape(b, n, DIFF_HEADS, 2, DIFF_HEAD_DIM).transpose(0, 2, 3, 1, 4)


def _diff_core(q, k, v, lam, scale):
    s = jnp.einsum('bhmqd,bhmkd->bhmqk', q, k).astype(jnp.float32) * scale
    p = jax.nn.softmax(s, axis=-1)
    a = (p[:, :, 0] - lam * p[:, :, 1]).astype(v.dtype)
    return jnp.einsum('bhqk,bhkv->bhqv', a, v)


def _diff_mixer(q, k, v, qc, kc, vc, lam_params, subln_g, lambda_init, cos, sin, need_ctx):
    scale = DIFF_HEAD_DIM ** -0.5
    lp = lam_params.astype(jnp.float32)
    lam = jnp.exp(jnp.sum(lp[0] * lp[1])) - jnp.exp(jnp.sum(lp[2] * lp[3])) + lambda_init
    q = _apply_axial_rope(_diff_heads(q), cos, sin)
    k = _apply_axial_rope(_diff_heads(k), cos, sin)
    v = _split_heads(v, DIFF_HEADS)
    kc = _diff_heads(kc)
    vc = _split_heads(vc, DIFF_HEADS)
    k_all = jnp.concatenate([k, kc], axis=3)
    v_all = jnp.concatenate([v, vc], axis=2)
    b, h, _, n, d = q.shape
    nb = n // Q_BLOCK
    q_blocks = jnp.moveaxis(q.reshape(b, h, 2, nb, Q_BLOCK, d), 3, 0)
    y = lax.map(lambda qb: _diff_core(qb, k_all, v_all, lam, scale), q_blocks)
    y = jnp.moveaxis(y, 0, 2).reshape(b, h, n, 2 * d)

    def finish(t):
        return _merge_heads(_rms_norm(t, subln_g) * (1.0 - lambda_init))

    y_ctx = None
    if need_ctx:
        y_ctx = finish(_diff_core(_diff_heads(qc), kc, vc, lam, scale))
    return finish(y), y_ctx


def setup_inputs(seed: int = 0) -> dict:
    key = jax.random.key(seed)
    ks = jax.random.split(key, 13)
    f32 = jnp.float32
    x = jax.random.normal(ks[0], (BATCH, SEQ, D_MODEL), f32)
    c = jax.random.normal(ks[1], (BATCH, D_MODEL), f32)
    ctx = jax.random.normal(ks[2], (BATCH, CTX_LEN, D_MODEL), f32)
    c_ctx = jax.random.normal(ks[3], (D_MODEL,), f32)
    w_mod = jax.random.normal(ks[4], (DEPTH, D_MODEL, 3 * D_MODEL), f32) * (0.5 * D_MODEL ** -0.5)
    b_mod = 0.02 * jax.random.normal(ks[5], (DEPTH, 3 * D_MODEL), f32)
    w_in = jax.random.normal(ks[6], (DEPTH, D_MODEL, 4 * WIDTH), f32) * (D_MODEL ** -0.5)
    w_out = jax.random.normal(ks[7], (DEPTH, WIDTH, D_MODEL), f32) * (WIDTH ** -0.5 * DEEPNORM_BETA)
    ln_g = 1.0 + 0.02 * jax.random.normal(ks[8], (DEPTH, D_MODEL), f32)
    ln_b = 0.02 * jax.random.normal(ks[9], (DEPTH, D_MODEL), f32)
    na_rpb = 0.1 * jax.random.normal(ks[10], (N_NA_LAYERS, NA_HEADS, 2 * NA_WIN_R - 1, 2 * NA_WIN_C - 1), f32)
    diff_lambda = 0.1 * jax.random.normal(ks[11], (N_DIFF_LAYERS, 4, DIFF_HEAD_DIM), f32)
    diff_subln_g = 1.0 + 0.02 * jax.random.normal(ks[12], (N_DIFF_LAYERS, 2 * DIFF_HEAD_DIM), f32)
    return {'x': x, 'c': c, 'ctx': ctx, 'c_ctx': c_ctx, 'w_mod': w_mod, 'b_mod': b_mod,
            'w_in': w_in, 'w_out': w_out, 'ln_g': ln_g, 'ln_b': ln_b, 'na_rpb': na_rpb,
            'diff_lambda': diff_lambda, 'diff_subln_g': diff_subln_g}


def reference(x, c, ctx, c_ctx, w_mod, b_mod, w_in, w_out, ln_g, ln_b, na_rpb, diff_lambda, diff_subln_g):
    cos, sin = _axial_rope_tables(x.shape[1])
    for l in range(DEPTH):
        need_ctx = l < DEPTH - 1
        sh, sc, g = _modulation(c, w_mod[l], b_mod[l])
        sh, sc, g = sh[:, None, :], sc[:, None, :], g[:, None, :]
        shc, scc, gc = _modulation(c_ctx, w_mod[l], b_mod[l])
        h = x * (1.0 + sc) + sh
        hc = ctx * (1.0 + scc) + shc
        q, k, v, z = jnp.split(h @ w_in[l], 4, axis=-1)
        if need_ctx:
            qc, kc, vc, zc = jnp.split(hc @ w_in[l], 4, axis=-1)
        else:
            kc, vc = jnp.split(hc @ w_in[l][:, WIDTH:3 * WIDTH], 2, axis=-1)
            qc, zc = None, None
        if l % N_MIXERS == 0:
            y, yc = _na_mixer(q, k, v, qc, kc, vc, na_rpb[l // N_MIXERS], need_ctx)
        else:
            lambda_init = 0.8 - 0.6 * math.exp(-0.3 * l)
            y, yc = _diff_mixer(q, k, v, qc, kc, vc, diff_lambda[l // N_MIXERS], diff_subln_g[l // N_MIXERS],
                                lambda_init, cos, sin, need_ctx)
        out = (y * jax.nn.silu(z)) @ w_out[l]
        x_new = _layer_norm(DEEPNORM_ALPHA * x + (1.0 + g) * out, ln_g[l], ln_b[l])
        if need_ctx:
            out_c = (yc * jax.nn.silu(zc)) @ w_out[l]
            ctx = _layer_norm(DEEPNORM_ALPHA * ctx + (1.0 + gc) * out_c, ln_g[l], ln_b[l])
        x = x_new
    return x
```

```cpp
#include <hip/hip_runtime.h>
#include <hip/hip_cooperative_groups.h>
#include <cstdio>
#include <cstdint>
namespace cg = cooperative_groups;
#define N_LAUNCH_MODE 0
namespace pg8 {
#define PG8_LAS __attribute__((address_space(3)))
typedef unsigned short bf16_t;
typedef short bf16x8 __attribute__((ext_vector_type(8)));
typedef float f32x4 __attribute__((ext_vector_type(4)));
typedef unsigned u32x4 __attribute__((ext_vector_type(4)));
constexpr int BM = 256, BK = 64, HALF = 128, HTB = HALF * BK * 2  , STAGE_BYTES = 8 * HTB, NXCD = 8, WGM = 8;

__host__ __device__ __forceinline__ int lds_byte(int r, int c) { const int st = (r >> 4) * 2 + (c >> 5), rr = r & 15, cc = c & 31, ob = rr * 64 + cc * 2; return st * 1024 + (ob ^ (((ob >> 9) & 1) << 5)); }
__host__ __device__ __forceinline__ void stage_rc(int b, int& R, int& C) { const int st = b / 1024, sb = b % 1024, swz = sb ^ (((sb >> 9) & 1) << 5); R = (st >> 1) * 16 + swz / 64; C = (st & 1) * 32 + (swz % 64) / 2; }
__host__ __device__ __forceinline__ int perm32(int rho) { const int n = rho >> 4, i = rho & 15; return 8 * (i >> 2) + 4 * n + (i & 3); }

struct Unit { int pm, pn; };
struct Gemm { const bf16_t* A; const bf16_t* Bt; int M, N, K; };

struct StaticOrder {
    int nM, nN, nwg, G, c;
    __host__ __device__ void init(int M, int N, int G_, int c_) { nM = M / BM; nN = N / BM; nwg = nM * nN; G = G_; c = c_; }
    __host__ __device__ bool next(int i, Unit& u) const {
        const long L = (long)i * G + c; if (L >= nwg) return false;
        int wgid = (int)L; { const int q = nwg / NXCD, r = nwg % NXCD, xcd = wgid % NXCD, off = wgid / NXCD; wgid = (xcd < r ? xcd * (q + 1) : r * (q + 1) + (xcd - r) * q) + off; }
        const int nig = WGM * nN, gid = wgid / nig, fm = gid * WGM, gsz = (nM - fm) < WGM ? (nM - fm) : WGM;
        u.pm = fm + ((wgid % nig) % gsz); u.pn = (wgid % nig) / gsz; return true;
    }
    __device__ __forceinline__ void a_ready(const Unit&) const {}
    __device__ __forceinline__ void done(const Unit&) const {}
};
__device__ __forceinline__ unsigned cvt_pk_bf16(float lo, float hi) { unsigned r; asm volatile("v_cvt_pk_bf16_f32 %0, %1, %2" : "=v"(r) : "v"(lo), "v"(hi)); return r; }
template <class Epi, class Sched, bool ALIGN_EPI = false, bool SP2 = false>
__device__ __forceinline__ void gemm_phase(PG8_LAS unsigned char* lds, const Gemm g, const Sched& S, const Epi& E) {
    int tid_o = threadIdx.x; asm volatile("" : "+v"(tid_o));
    const int tid = tid_o, wid = __builtin_amdgcn_readfirstlane(tid >> 6), lane = tid & 63, wr = wid >> 2, wc = wid & 3, fr = lane & 15, fq = lane >> 4;
    const int K = g.K, nt = K / BK;
    unsigned voffA[2], voffB[2];
#pragma unroll
    for (int i = 0; i < 2; ++i) { int R, C; stage_rc(tid * 16 + i * 8192, R, C); const int Rb = Epi::PERM ? ((R & ~31) + perm32(R & 31)) : R;
        voffA[i] = (unsigned)(R * K + C) * 2u; voffB[i] = (unsigned)(Rb * K + C) * 2u; }
    const size_t kstep = (size_t)(BK * 2);
    const size_t hstep = (size_t)HALF * K * 2;
    const size_t tstep = 2 * hstep;
    const unsigned ldsw = (unsigned)wid * 1024u;
    const int aoff = lds_byte(wr * 64 + fr, fq * 8), boff = lds_byte(wc * 32 + fr, fq * 8);
#define PG8_SA(b, h) (((b) * 2 + (h)) * HTB)
#define PG8_SB(b, h) ((4 + (b) * 2 + (h)) * HTB)
#define PG8_STAGE(bufoff, gbase, voff) do { _Pragma("unroll") for (int _i = 0; _i < 2; ++_i) \
        __builtin_amdgcn_global_load_lds((const unsigned*)((const char*)(gbase) + (voff)[_i]), (PG8_LAS unsigned*)(lds + (bufoff) + ldsw + _i * 8192), 16, 0, 0); } while (0)
#define PG8_LDA(dst, b, h) do { _Pragma("unroll") for (int m = 0; m < 4; ++m) _Pragma("unroll") for (int k = 0; k < 2; ++k) dst[m][k] = *(const PG8_LAS bf16x8*)(lds + PG8_SA(b, h) + aoff + m * 2048 + k * 1024); } while (0)
#define PG8_LDB(dst, b, h) do { _Pragma("unroll") for (int n = 0; n < 2; ++n) _Pragma("unroll") for (int k = 0; k < 2; ++k) dst[n][k] = *(const PG8_LAS bf16x8*)(lds + PG8_SB(b, h) + boff + n * 2048 + k * 1024); } while (0)
#define PG8_MMA(ai, bj, At, Bt) do { __builtin_amdgcn_s_setprio(1); _Pragma("unroll") for (int m = 0; m < 4; ++m) _Pragma("unroll") for (int n = 0; n < 2; ++n) _Pragma("unroll") for (int k = 0; k < 2; ++k) \
        acc[ai][bj][m][n] = __builtin_amdgcn_mfma_f32_16x16x32_bf16(Bt[n][k], At[m][k], acc[ai][bj][m][n], 0, 0, 0); __builtin_amdgcn_s_setprio(0); } while (0)
#define PG8_WAIT_V(n) asm volatile("s_waitcnt vmcnt(" #n ")" ::: "memory")
#define PG8_WAIT_L(n) asm volatile("s_waitcnt lgkmcnt(" #n ")" ::: "memory")
#define PG8_BAR __builtin_amdgcn_s_barrier()
#define PG8_SCHED __builtin_amdgcn_sched_barrier(0)
    Unit cur, nxt; int ui = 0;
    if (!S.next(0, cur)) return;
    f32x4 acc[2][2][4][2];
#pragma unroll
    for (int a = 0; a < 2; ++a)
#pragma unroll
        for (int b = 0; b < 2; ++b)
#pragma unroll
            for (int m = 0; m < 4; ++m)
#pragma unroll
                for (int n = 0; n < 2; ++n) acc[a][b][m][n] = (f32x4){0.f, 0.f, 0.f, 0.f};
    bf16x8 At[4][2], B0[2][2], B1[2][2];
    const char* cA = (const char*)g.A + (size_t)cur.pm * tstep; const char* cB = (const char*)g.Bt + (size_t)cur.pn * tstep;
    S.a_ready(cur);
    if constexpr (SP2) {
        PG8_STAGE(PG8_SB(0, 0), cB, voffB); PG8_STAGE(PG8_SB(0, 1), cB + hstep, voffB); PG8_STAGE(PG8_SA(0, 0), cA, voffA); PG8_STAGE(PG8_SA(0, 1), cA + hstep, voffA);
        if (wr == 1) PG8_BAR;
        PG8_WAIT_V(2); PG8_BAR;
        PG8_STAGE(PG8_SB(1, 0), cB + kstep, voffB); PG8_STAGE(PG8_SA(1, 0), cA + kstep, voffA); PG8_STAGE(PG8_SB(1, 1), cB + hstep + kstep, voffB);
        PG8_WAIT_V(6); PG8_BAR;
    } else {
        PG8_STAGE(PG8_SB(0, 0), cB, voffB); PG8_STAGE(PG8_SA(0, 0), cA, voffA); PG8_STAGE(PG8_SB(0, 1), cB + hstep, voffB); PG8_STAGE(PG8_SA(0, 1), cA + hstep, voffA);
        if (wr == 1) PG8_BAR;
        PG8_WAIT_V(4); PG8_BAR;
        PG8_STAGE(PG8_SB(1, 0), cB + kstep, voffB); PG8_STAGE(PG8_SA(1, 0), cA + kstep, voffA); PG8_STAGE(PG8_SB(1, 1), cB + hstep + kstep, voffB);
        PG8_WAIT_V(6); PG8_BAR;
    }
    for (;;) {
        const bool has_next = S.next(ui + 1, nxt);
        const char* nA = has_next ? (const char*)g.A + (size_t)nxt.pm * tstep : cA; const char* nB = has_next ? (const char*)g.Bt + (size_t)nxt.pn * tstep : cB;
        for (int t = 0; t < nt; t += 2) {
            const bool last = (t == nt - 2);
            const char* a1 = cA + (size_t)(t + 1) * kstep;
            const char* a2 = last ? nA : cA + (size_t)(t + 2) * kstep; const char* b2 = last ? nB : cB + (size_t)(t + 2) * kstep;
            const char* a3 = a2 + kstep; const char* b3 = b2 + kstep;
            if (last && has_next) S.a_ready(nxt);
            if constexpr (SP2) {
            PG8_LDB(B0, 0, 0); PG8_LDB(B1, 0, 1); PG8_SCHED; PG8_LDA(At, 0, 0); PG8_STAGE(PG8_SA(1, 1), a1 + hstep, voffA);
            PG8_WAIT_V(8); PG8_WAIT_L(0); PG8_BAR; PG8_MMA(0, 0, At, B0); PG8_MMA(0, 1, At, B1); PG8_BAR; PG8_SCHED;
            PG8_LDA(At, 0, 1); PG8_STAGE(PG8_SB(0, 0), b2, voffB); PG8_STAGE(PG8_SB(0, 1), b2 + hstep, voffB); PG8_STAGE(PG8_SA(0, 0), a2, voffA);
            PG8_WAIT_V(8); PG8_WAIT_L(0); PG8_BAR; PG8_MMA(1, 0, At, B0); PG8_MMA(1, 1, At, B1); PG8_BAR; PG8_SCHED;
            PG8_LDB(B0, 1, 0); PG8_LDB(B1, 1, 1); PG8_SCHED; PG8_LDA(At, 1, 0); PG8_STAGE(PG8_SA(0, 1), a2 + hstep, voffA);
            PG8_WAIT_V(8); PG8_WAIT_L(0); PG8_BAR; PG8_MMA(0, 0, At, B0); PG8_MMA(0, 1, At, B1); PG8_BAR; PG8_SCHED;
            PG8_LDA(At, 1, 1); PG8_STAGE(PG8_SB(1, 0), b3, voffB); PG8_STAGE(PG8_SB(1, 1), b3 + hstep, voffB); PG8_STAGE(PG8_SA(1, 0), a3, voffA);
            PG8_WAIT_V(8); PG8_WAIT_L(0); PG8_BAR; PG8_MMA(1, 0, At, B0); PG8_MMA(1, 1, At, B1); PG8_BAR; PG8_SCHED;
            } else {
            PG8_LDB(B0, 0, 0); PG8_SCHED; PG8_LDA(At, 0, 0); PG8_STAGE(PG8_SA(1, 1), a1 + hstep, voffA);
            PG8_WAIT_L(8); PG8_BAR; PG8_WAIT_L(0); PG8_MMA(0, 0, At, B0); PG8_BAR; PG8_SCHED;
            PG8_LDB(B1, 0, 1); PG8_STAGE(PG8_SB(0, 0), b2, voffB);
            PG8_BAR; PG8_WAIT_L(0); PG8_MMA(0, 1, At, B1); PG8_BAR;
            PG8_LDA(At, 0, 1); PG8_STAGE(PG8_SA(0, 0), a2, voffA);
            PG8_BAR; PG8_WAIT_L(0); PG8_MMA(1, 0, At, B0); PG8_BAR; PG8_SCHED;
            PG8_STAGE(PG8_SB(0, 1), b2 + hstep, voffB);
            PG8_WAIT_V(6); PG8_BAR; PG8_MMA(1, 1, At, B1); PG8_BAR;
            PG8_LDB(B0, 1, 0); PG8_SCHED; PG8_LDA(At, 1, 0); PG8_STAGE(PG8_SA(0, 1), a2 + hstep, voffA);
            PG8_WAIT_L(8); PG8_BAR; PG8_WAIT_L(0); PG8_MMA(0, 0, At, B0); PG8_BAR; PG8_SCHED;
            PG8_LDB(B1, 1, 1); PG8_STAGE(PG8_SB(1, 0), b3, voffB);
            PG8_BAR; PG8_WAIT_L(0); PG8_MMA(0, 1, At, B1); PG8_BAR;
            PG8_LDA(At, 1, 1); PG8_STAGE(PG8_SA(1, 0), a3, voffA);
            PG8_BAR; PG8_WAIT_L(0); PG8_MMA(1, 0, At, B0); PG8_BAR; PG8_SCHED;
            PG8_STAGE(PG8_SB(1, 1), b3 + hstep, voffB);
            PG8_WAIT_V(6); PG8_BAR; PG8_MMA(1, 1, At, B1); PG8_BAR;
            }
        }
        if constexpr (ALIGN_EPI) { if (wr == 0) PG8_BAR; }
        if constexpr (!Epi::AFTER_DRAIN) { E(acc, cur, wr, wc, fr, fq); S.done(cur); }
        if (!has_next) break;
#pragma unroll
        for (int a = 0; a < 2; ++a)
#pragma unroll
            for (int b = 0; b < 2; ++b)
#pragma unroll
                for (int m = 0; m < 4; ++m)
#pragma unroll
                    for (int n = 0; n < 2; ++n) acc[a][b][m][n] = (f32x4){0.f, 0.f, 0.f, 0.f};
        cur = nxt; cA = nA; cB = nB; ++ui;
        if constexpr (ALIGN_EPI) { if (wr == 1) PG8_BAR; }
    }
    PG8_WAIT_V(0);
    if constexpr (!ALIGN_EPI) { if (wr == 0) PG8_BAR; }
    PG8_BAR;
    if constexpr (Epi::AFTER_DRAIN) { E.fused(acc, cur, wr, wc, fr, fq, lds, wid, lane); S.done(cur); }
#undef PG8_SA
#undef PG8_SB
#undef PG8_STAGE
#undef PG8_LDA
#undef PG8_LDB
#undef PG8_MMA
#undef PG8_WAIT_V
#undef PG8_WAIT_L
#undef PG8_BAR
#undef PG8_SCHED
}
}

#define GAS __attribute__((address_space(1)))
#define LAS __attribute__((address_space(3)))
typedef unsigned short bf16;
typedef unsigned v4u __attribute__((ext_vector_type(4)));
typedef unsigned v2u __attribute__((ext_vector_type(2)));
typedef float f32x4 __attribute__((ext_vector_type(4)));
typedef float f32x16 __attribute__((ext_vector_type(16)));
typedef short bf16x8 __attribute__((ext_vector_type(8)));
typedef short s16x4 __attribute__((ext_vector_type(4)));
#define LDS_WAIT() asm volatile("s_waitcnt lgkmcnt(0)" ::: "memory")
#define VM_WAIT() asm volatile("s_waitcnt vmcnt(0)" ::: "memory")

constexpr int DM = 1024, NB = 8, SEQ = 4096, CTXL = 256, DEPTH = 4;
constexpr int MX = NB * SEQ, MC = NB * CTXL, MT = MX + MC;
constexpr float ALPHA = 1.681792830507429f;
constexpr float LN_EPS = 1e-5f;
constexpr float LOG2E = 1.4426950408889634f;
constexpr float QSCALE = 0.125f * LOG2E;
constexpr int NWAVES = 8;
constexpr int NPH = 2 + 4 * DEPTH;

constexpr size_t MiB = 1u << 20;
constexpr size_t WS_MOD = 1 * MiB;
constexpr size_t WS_COS = 1 * MiB + 512 * 1024, WS_SIN = WS_COS + 4096;
constexpr size_t WS_WIN = 2 * MiB;
constexpr size_t WS_WOUT = 34 * MiB;
constexpr size_t WS_XRC = 42 * MiB;
constexpr size_t WS_XN = 50 * MiB;
constexpr size_t ACT = (size_t)68 * MiB;
constexpr size_t WS_Q = 118 * MiB, WS_K = WS_Q + ACT, WS_V = WS_K + ACT, WS_Z = WS_V + ACT, WS_YZ = WS_Z + ACT, WS_END = WS_YZ + ACT;
constexpr int LDS_BYTES = 147456;

__device__ __forceinline__ unsigned f2bf(float f) { unsigned u = __builtin_bit_cast(unsigned, f); return (u + 0x7fffu + ((u >> 16) & 1u)) >> 16; }
__device__ __forceinline__ unsigned pk2(float lo, float hi) { return f2bf(lo) | (f2bf(hi) << 16); }
typedef float f32x2_t __attribute__((ext_vector_type(2))); typedef __bf16 bf16x2_t __attribute__((ext_vector_type(2)));
__device__ __forceinline__ unsigned cvtpk(float lo, float hi) { f32x2_t v = {lo, hi}; bf16x2_t b = __builtin_convertvector(v, bf16x2_t); return __builtin_bit_cast(unsigned, b); }
__device__ __forceinline__ float bflo(unsigned u) { return __builtin_bit_cast(float, u << 16); }
__device__ __forceinline__ float bfhi(unsigned u) { return __builtin_bit_cast(float, u & 0xffff0000u); }
__device__ __forceinline__ float wave_sum(float v) {
#pragma unroll
    for (int o = 1; o < 64; o <<= 1) v += __shfl_xor(v, o);
    return v;
}
__device__ __forceinline__ float silu_f(float v) { return v / (1.f + __expf(-v)); }

namespace pg8 {
struct EpiIn {
    static constexpr bool PERM = true, AFTER_DRAIN = false;
    bf16_t* Q; size_t stride; int rope; const float* cosT; const float* sinT;
    __device__ __forceinline__ void operator()(const f32x4 (&acc)[2][2][4][2], const Unit& u, int wr, int wc, int fr, int fq) const {
        const int t = u.pn >> 2, colt = (u.pn & 3) * 256;
        bf16_t* base = Q + (size_t)t * stride;
        const int row0 = u.pm * BM + wr * 64 + fr, col0 = colt + wc * 32 + 8 * fq;
        const bool do_rope = rope && t < 2 && u.pm < (MX / BM);
        const int half = wc & 1, f0 = 8 * (fq & 1);
        const float sgn = (fq >> 1) ? 1.f : -1.f;
#pragma unroll
        for (int ai = 0; ai < 2; ++ai)
#pragma unroll
            for (int m = 0; m < 4; ++m) {
                const int row = row0 + ai * HALF + m * 16;
                bf16_t* rowp = base + (size_t)row * 1024 + col0;
                f32x4 c0 = {1.f, 1.f, 1.f, 1.f}, c1 = c0, s0 = {0.f, 0.f, 0.f, 0.f}, s1 = s0;
                if (do_rope) { const int tok = row & (SEQ - 1); const int pos = half ? (tok & 63) : (tok >> 6);
                    c0 = *(const f32x4*)(cosT + pos * 16 + f0); c1 = *(const f32x4*)(cosT + pos * 16 + f0 + 4);
                    s0 = *(const f32x4*)(sinT + pos * 16 + f0) * sgn; s1 = *(const f32x4*)(sinT + pos * 16 + f0 + 4) * sgn; }
#pragma unroll
                for (int bj = 0; bj < 2; ++bj) {
                    f32x4 v0 = acc[ai][bj][m][0], v1 = acc[ai][bj][m][1];
                    if (t == 3) {
#pragma unroll
                        for (int j = 0; j < 4; ++j) { v0[j] = silu_f(v0[j]); v1[j] = silu_f(v1[j]); }
                    } else if (do_rope) {
                        f32x4 p0, p1;
#pragma unroll
                        for (int j = 0; j < 4; ++j) { p0[j] = __shfl_xor(v0[j], 32); p1[j] = __shfl_xor(v1[j], 32); }
                        v0 = v0 * c0 + p0 * s0; v1 = v1 * c1 + p1 * s1;
                    }
                    if (t == 0) { v0 = v0 * QSCALE; v1 = v1 * QSCALE; }
                    u32x4 w; w.x = cvt_pk_bf16(v0[0], v0[1]); w.y = cvt_pk_bf16(v0[2], v0[3]); w.z = cvt_pk_bf16(v1[0], v1[1]); w.w = cvt_pk_bf16(v1[2], v1[3]);
                    *(u32x4*)(rowp + bj * HALF) = w;
                }
            }
    }
};
struct EpiOut {
    static constexpr bool PERM = false, AFTER_DRAIN = false;
    const float* res_x; const float* res_c; float* out_x; float* out_c; const float* modl;
    __device__ __forceinline__ void operator()(const f32x4 (&acc)[2][2][4][2], const Unit& u, int wr, int wc, int fr, int fq) const {
        const bool isc = u.pm >= (MX / BM);
        const int rbase = (isc ? u.pm - MX / BM : u.pm) * BM + wr * 64 + fr;
        const float* res = isc ? res_c : res_x; float* out = isc ? out_c : out_x;
        const int bidx = isc ? 8 : (u.pm >> 4);
        const int col0 = u.pn * BM + wc * 32 + 4 * fq;
        const float* g = modl + bidx * 3072 + 2048 + col0;
        f32x4 gv[2][2];
#pragma unroll
        for (int bj = 0; bj < 2; ++bj)
#pragma unroll
            for (int n = 0; n < 2; ++n) gv[bj][n] = *(const f32x4*)(g + bj * HALF + n * 16) + 1.f;
#pragma unroll
        for (int ai = 0; ai < 2; ++ai)
#pragma unroll
            for (int m = 0; m < 4; ++m) { const size_t off = (size_t)(rbase + ai * HALF + m * 16) * 1024 + col0;
#pragma unroll
                for (int bj = 0; bj < 2; ++bj)
#pragma unroll
                    for (int n = 0; n < 2; ++n) { const f32x4 r4 = *(const f32x4*)(res + off + bj * HALF + n * 16);
                        *(f32x4*)(out + off + bj * HALF + n * 16) = r4 * ALPHA + gv[bj][n] * acc[ai][bj][m][n]; }
                if (m & 1) asm volatile("" ::: "memory"); }
    }
};
}

#define MFMA32(a, b, c) __builtin_amdgcn_mfma_f32_32x32x16_bf16((a), (b), (c), 0, 0, 0)
typedef short v4i16_t __attribute__((ext_vector_type(4)));
__device__ __forceinline__ s16x4 vtr(const LAS unsigned char* p) { return __builtin_bit_cast(s16x4, __builtin_amdgcn_ds_read_tr16_b64_v4i16((LAS v4i16_t*)p)); }
__device__ __forceinline__ int crow(int r, int hi) { return (r & 3) + 8 * (r >> 2) + 4 * hi; }
__device__ __forceinline__ int clampi(int v, int lo, int hi) { return v < lo ? lo : (v > hi ? hi : v); }

template <int NMAPS, int DVB, bool NA, bool SPLIT>
__device__ __forceinline__ void attn_unit(LAS unsigned char* lds, const bf16* Q, const bf16* Km, const bf16* Vm, const bf16* SZ, bf16* YZ,
                                          int q_row0, int qcol, int vcol, int seg1, int n1, int seg2, int n2, int kr0, bool xunit, int rq0,
                                          const LAS float* rpbL, float lam, float omli, const float* subg) {
    constexpr int KMAPS = SPLIT ? 2 : NMAPS;
    constexpr int KB = 8192, STAGE = KMAPS * KB + DVB * 4096;
    int tid_o = threadIdx.x; asm volatile("" : "+v"(tid_o));
    const int tid = tid_o, lane = tid & 63, wid = __builtin_amdgcn_readfirstlane(tid >> 6), r32 = lane & 31, hi = lane >> 5;
    const int NT = n1 + n2;
    const int wq_off = SPLIT ? (wid & 3) * 32 : wid * 32, wmap = SPLIT ? (wid >> 2) : 0;
    bf16x8 qf[NMAPS][4];
    { const bf16* qp = Q + (size_t)(q_row0 + wq_off + r32) * 1024 + qcol + wmap * 64 + hi * 8;
#pragma unroll
      for (int m = 0; m < NMAPS; ++m)
#pragma unroll
          for (int d0 = 0; d0 < 4; ++d0) qf[m][d0] = *(const bf16x8*)(qp + m * 64 + d0 * 16); }
    float mrun[NMAPS], lrun[NMAPS]; f32x16 o[NMAPS][DVB];
#pragma unroll
    for (int m = 0; m < NMAPS; ++m) { mrun[m] = -1e30f; lrun[m] = 0.f;
#pragma unroll
        for (int d = 0; d < DVB; ++d)
#pragma unroll
            for (int r = 0; r < 16; ++r) o[m][d][r] = 0.f; }
    const unsigned koff = (unsigned)((wid * 8 + (lane >> 3)) * 1024 + qcol + (((lane & 7) ^ (lane >> 3)) * 8));
    unsigned voff[DVB / 2];
#pragma unroll
    for (int i = 0; i < DVB / 2; ++i) { const int p = wid + 8 * i, dvb = p >> 2, g8 = 2 * (p & 3) + (lane >> 5), row = g8 * 8 + ((lane & 31) >> 2);
        voff[i] = (unsigned)(row * 1024 + vcol + dvb * 32 + (lane & 3) * 8); }
#define ATT_ISSUE(t, buf) do { const int rb_ = (t) < n1 ? seg1 + 64 * (t) : seg2 + 64 * ((t) - n1); LAS unsigned char* sb_ = lds + (buf) * STAGE; \
        _Pragma("unroll") for (int m_ = 0; m_ < KMAPS; ++m_) __builtin_amdgcn_global_load_lds((const unsigned*)(Km + (size_t)rb_ * 1024 + koff + m_ * 64), (LAS unsigned*)(sb_ + m_ * KB + wid * 1024), 16, 0, 0); \
        _Pragma("unroll") for (int i_ = 0; i_ < DVB / 2; ++i_) __builtin_amdgcn_global_load_lds((const unsigned*)(Vm + (size_t)rb_ * 1024 + voff[i_]), (LAS unsigned*)(sb_ + KMAPS * KB + (wid + 8 * i_) * 1024), 16, 0, 0); } while (0)
    const int rqw = rq0 + (wid >> 1), r0w = clampi(rqw - 4, 0, 56);
    const int wq = 32 * (wid & 1) + r32, c0_ = clampi(wq - 8, 0, 48);
    const int kbyte = r32 * 128, kx = r32 & 7;
    const int vlane = (4 * hi + ((lane & 15) >> 2)) * 64 + ((lane >> 4) & 1) * 32 + (lane & 3) * 8;

    ATT_ISSUE(0, 0);
    VM_WAIT(); __syncthreads();
    for (int t = 0; t < NT; ++t) {
        if (t + 1 < NT) ATT_ISSUE(t + 1, (t + 1) & 1);
        const bool win = NA && xunit && t < n1;
        const int kr = kr0 + t;
        const bool active = !win || (kr >= r0w && kr <= r0w + 7);
        if (active) {
            const LAS unsigned char* sb = lds + (t & 1) * STAGE;
#pragma unroll
            for (int m = 0; m < NMAPS; ++m) {
                f32x16 s0, s1;
#pragma unroll
                for (int r = 0; r < 16; ++r) { s0[r] = 0.f; s1[r] = 0.f; }
                const LAS unsigned char* kb_ = sb + (m + wmap) * KB + kbyte;
#pragma unroll
                for (int d0 = 0; d0 < 4; ++d0) {
                    const int ch = ((2 * d0 + hi) ^ kx) * 16;
                    const bf16x8 a0 = *(const LAS bf16x8*)(kb_ + ch);
                    const bf16x8 a1 = *(const LAS bf16x8*)(kb_ + 4096 + ch);
                    s0 = MFMA32(a0, qf[m][d0], s0); s1 = MFMA32(a1, qf[m][d0], s1);
                }
                if (win) {
                    const int dr = (kr - rqw + 7) * 31;
                    int c0 = c0_; asm volatile("" : "+v"(c0));
#pragma unroll
                    for (int r = 0; r < 16; ++r) {
                        const int kc0 = crow(r, hi), kc1 = kc0 + 32;
                        const bool v0 = (unsigned)(kc0 - c0) < 16u, v1 = (unsigned)(kc1 - c0) < 16u;
                        const int i0 = v0 ? dr + kc0 - wq + 15 : 0, i1 = v1 ? dr + kc1 - wq + 15 : 0;
                        const float b0 = rpbL[i0], b1 = rpbL[i1];
                        s0[r] = v0 ? s0[r] + b0 : -1e30f; s1[r] = v1 ? s1[r] + b1 : -1e30f;
                    }
                }
                float mx = fmaxf(s0[0], s1[0]);
#pragma unroll
                for (int r = 1; r < 16; ++r) mx = fmaxf(mx, fmaxf(s0[r], s1[r]));
                mx = fmaxf(mx, __shfl_xor(mx, 32));
                const float mn = fmaxf(mrun[m], mx), al = __builtin_amdgcn_exp2f(mrun[m] - mn);
                mrun[m] = mn;
                float ls = 0.f;
#pragma unroll
                for (int r = 0; r < 16; ++r) { s0[r] = __builtin_amdgcn_exp2f(s0[r] - mn); s1[r] = __builtin_amdgcn_exp2f(s1[r] - mn); ls += s0[r] + s1[r]; }
                lrun[m] = lrun[m] * al + ls;
#pragma unroll
                for (int d = 0; d < DVB; ++d)
#pragma unroll
                    for (int r = 0; r < 16; ++r) o[m][d][r] *= al;
                v4u pw[4];
#pragma unroll
                for (int j = 0; j < 4; ++j) { pw[0][j] = cvtpk(s0[2 * j], s0[2 * j + 1]); pw[1][j] = cvtpk(s0[8 + 2 * j], s0[8 + 2 * j + 1]);
                                              pw[2][j] = cvtpk(s1[2 * j], s1[2 * j + 1]); pw[3][j] = cvtpk(s1[8 + 2 * j], s1[8 + 2 * j + 1]); }
                const LAS unsigned char* vb_ = sb + KMAPS * KB + vlane;
#pragma unroll
                for (int d = 0; d < DVB; ++d)
#pragma unroll
                    for (int ks = 0; ks < 4; ++ks) {
                        const s16x4 lo = vtr(vb_ + (d * 8 + 2 * ks) * 512), h4 = vtr(vb_ + (d * 8 + 2 * ks + 1) * 512);
                        const bf16x8 vf = {lo[0], lo[1], lo[2], lo[3], h4[0], h4[1], h4[2], h4[3]};
                        o[m][d] = MFMA32(vf, __builtin_bit_cast(bf16x8, pw[ks]), o[m][d]);
                    }
            }
        }
        VM_WAIT(); __syncthreads();
    }
#undef ATT_ISSUE
    const size_t orow = (size_t)(q_row0 + wq_off + r32) * 1024 + vcol;
    if (!SPLIT) {
        const float inv = 1.f / (lrun[0] + __shfl_xor(lrun[0], 32));
#pragma unroll
        for (int d = 0; d < DVB; ++d)
#pragma unroll
            for (int i = 0; i < 4; ++i) { const int dv0 = d * 32 + 8 * i + 4 * hi;
                const v2u z = *(const v2u*)(SZ + orow + dv0);
                v2u w; w.x = cvtpk(o[0][d][4 * i] * inv * bflo(z.x), o[0][d][4 * i + 1] * inv * bfhi(z.x));
                w.y = cvtpk(o[0][d][4 * i + 2] * inv * bflo(z.y), o[0][d][4 * i + 3] * inv * bfhi(z.y));
                *(v2u*)(YZ + orow + dv0) = w; }
    } else {
        LAS float* ex = (LAS float*)(lds + 2 * STAGE) + (wid & 3) * (DVB * 16 * 64) + lane;
        const float inv = (wmap ? lam : 1.f) / (lrun[0] + __shfl_xor(lrun[0], 32));
        if (wmap) {
#pragma unroll
            for (int d = 0; d < DVB; ++d)
#pragma unroll
                for (int r = 0; r < 16; ++r) ex[(d * 16 + r) * 64] = o[0][d][r] * inv;
        }
        __syncthreads();
        if (!wmap) {
            float ss = 0.f;
#pragma unroll
            for (int d = 0; d < DVB; ++d)
#pragma unroll
                for (int r = 0; r < 16; ++r) { const float tv = o[0][d][r] * inv - ex[(d * 16 + r) * 64]; o[0][d][r] = tv; ss += tv * tv; }
            ss += __shfl_xor(ss, 32);
            const float rn = rsqrtf(ss * (1.f / (32.f * DVB)) + LN_EPS);
#pragma unroll
            for (int d = 0; d < DVB; ++d)
#pragma unroll
                for (int i = 0; i < 4; ++i) { const int dv0 = d * 32 + 8 * i + 4 * hi;
                    const v2u z = *(const v2u*)(SZ + orow + dv0);
                    const f32x4 g4 = *(const f32x4*)(subg + dv0) * omli;
                    v2u w; w.x = cvtpk(o[0][d][4 * i] * rn * g4[0] * bflo(z.x), o[0][d][4 * i + 1] * rn * g4[1] * bfhi(z.x));
                    w.y = cvtpk(o[0][d][4 * i + 2] * rn * g4[2] * bflo(z.y), o[0][d][4 * i + 3] * rn * g4[3] * bfhi(z.y));
                    *(v2u*)(YZ + orow + dv0) = w; }
        }
        __syncthreads();
    }
}

__device__ __forceinline__ void p0_transpose_item(const float* W, int K, int N, bf16* WT, int row_off, LAS float* scr, int item, int lane) {
    const int nblk = N / 32, kb = item / nblk, nb = item % nblk, k0 = 64 * kb, n0 = 32 * nb;
#pragma unroll 8
    for (int i = 0; i < 32; ++i) { const int kk = 2 * i + (lane >> 5); scr[kk * 33 + (lane & 31)] = W[(size_t)(k0 + kk) * N + n0 + (lane & 31)]; }
    LDS_WAIT(); asm volatile("" ::: "memory");
    const int c = lane & 7;
#pragma unroll
    for (int j = 0; j < 4; ++j) { const int n = (lane >> 3) + 8 * j; const LAS float* s = scr + (8 * c) * 33 + n;
        v4u o; o.x = pk2(s[0 * 33], s[1 * 33]); o.y = pk2(s[2 * 33], s[3 * 33]); o.z = pk2(s[4 * 33], s[5 * 33]); o.w = pk2(s[6 * 33], s[7 * 33]);
        *(GAS v4u*)(WT + (size_t)(row_off + n0 + n) * K + k0 + 8 * c) = o; }
    LDS_WAIT(); asm volatile("" ::: "memory");
}

__device__ __forceinline__ void sincos_d(double x, double& s, double& c) {
    const double n = __builtin_rint(x * 0.63661977236758134308);
    const double r = (x - n * 1.57079632679489655800) - n * 6.12323399573676603587e-17;
    const double r2 = r * r;
    double sp = -7.6471637318198164759e-13; sp = sp * r2 + 1.6059043836821614599e-10; sp = sp * r2 - 2.5052108385441718775e-08; sp = sp * r2 + 2.7557319223985890653e-06;
    sp = sp * r2 - 1.9841269841269841270e-04; sp = sp * r2 + 8.3333333333333333333e-03; sp = sp * r2 - 1.6666666666666666667e-01; sp = r + r * r2 * sp;
    double cp = 4.7794773323873852974e-14; cp = cp * r2 - 1.1470745597729724714e-11; cp = cp * r2 + 2.0876756987868098979e-09; cp = cp * r2 - 2.7557319223985890653e-07;
    cp = cp * r2 + 2.4801587301587301587e-05; cp = cp * r2 - 1.3888888888888888889e-03; cp = cp * r2 + 4.1666666666666666667e-02; cp = cp * r2 - 0.5; cp = 1.0 + r2 * cp;
    const int q = ((int)n) & 3;
    s = (q == 0) ? sp : (q == 1) ? cp : (q == 2) ? -sp : -cp;
    c = (q == 0) ? cp : (q == 1) ? -sp : (q == 2) ? -cp : sp;
}

struct Args { const float* in[13]; float* out; unsigned char* ws; int ph_lo, ph_hi; };

__global__ void __launch_bounds__(NWAVES * 64, 2) fwd_kernel(Args args) {
    extern __shared__ __attribute__((aligned(16))) unsigned char lds_raw[];
    LAS unsigned char* lds = (LAS unsigned char*)lds_raw;
    cg::grid_group grid = cg::this_grid();
    const int tid0 = threadIdx.x, wave = __builtin_amdgcn_readfirstlane(tid0 >> 6);
#define OPAQUE_TID() int tid = tid0; asm volatile("" : "+v"(tid)); const int lane = tid & 63
    const int G = gridDim.x, bx = blockIdx.x;
    const int vcu = (G % 8 == 0) ? (bx % 8) * (G / 8) + bx / 8 : bx;
    const int gw = vcu * NWAVES + wave, NGW = G * NWAVES;
    unsigned char* ws = args.ws;
    const float* x_in = args.in[0]; const float* c_in = args.in[1]; const float* ctx_in = args.in[2]; const float* cctx_in = args.in[3];
    const float* w_mod = args.in[4]; const float* b_mod = args.in[5]; const float* w_in = args.in[6]; const float* w_out = args.in[7];
    const float* ln_g = args.in[8]; const float* ln_b = args.in[9]; const float* na_rpb = args.in[10]; const float* diff_lambda = args.in[11]; const float* diff_subln = args.in[12];
    float* modT = (float*)(ws + WS_MOD); float* cosT = (float*)(ws + WS_COS); float* sinT = (float*)(ws + WS_SIN);
    bf16* Win_t = (bf16*)(ws + WS_WIN); bf16* Wout_t = (bf16*)(ws + WS_WOUT);
    float* XRx = args.out; float* XRc = (float*)(ws + WS_XRC);
    bf16* XN = (bf16*)(ws + WS_XN); bf16* Qb = (bf16*)(ws + WS_Q); bf16* Kb = (bf16*)(ws + WS_K); bf16* Vb = (bf16*)(ws + WS_V); bf16* Zb = (bf16*)(ws + WS_Z); bf16* YZ = (bf16*)(ws + WS_YZ);
    const int lo = args.ph_lo, hi_ph = args.ph_hi;
#define IN_PH(k) (lo <= (k) && (k) < hi_ph)
#define SEAM(k) do { if (lo <= (k) && (k) + 1 < hi_ph) grid.sync(); } while (0)

    if (IN_PH(0)) {
        OPAQUE_TID();
        LAS float* scr = (LAS float*)(lds + wave * 16384);
        constexpr int PER_L = 2048 + 512, NIT = DEPTH * PER_L;
        for (int it = gw; it < NIT; it += NGW) {
            const int l = it / PER_L, r = it % PER_L;
            if (r < 2048) p0_transpose_item(w_in + (size_t)l * 1024 * 4096, 1024, 4096, Win_t + (size_t)l * 4096 * 1024, 0, scr, r, lane);
            else p0_transpose_item(w_out + (size_t)l * 1024 * 1024, 1024, 1024, Wout_t + (size_t)l * 1024 * 1024, 0, scr, r - 2048, lane);
        }
        { const int gt = bx * (NWAVES * 64) + tid;
          if (gt < 1024) { const float invf[16] = {1.0f, 0.5623413324356079f, 0.3162277638912201f, 0.17782793939113617f, 0.10000000149011612f, 0.05623413249850273f, 0.03162277489900589f, 0.017782794311642647f,
                                                   0.009999999776482582f, 0.005623413249850273f, 0.003162277629598975f, 0.0017782794311642647f, 0.0010000000474974513f, 0.000562341301701963f, 0.0003162277571391314f, 0.00017782794020604342f};
              const int pos = gt >> 4, f = gt & 15; float fv = invf[0];
#pragma unroll
              for (int q = 1; q < 16; ++q) fv = (f == q) ? invf[q] : fv;
              const float ang = (float)pos * fv; double s, c; sincos_d((double)ang, s, c); cosT[gt] = (float)c; sinT[gt] = (float)s; } }
        __syncthreads();
        LAS float* sil = (LAS float*)lds;
        LAS float* red = sil + 9 * 1024;
        for (int i = tid; i < 9 * 1024; i += NWAVES * 64) { const int j = i >> 10, k = i & 1023; const float cv = j < 8 ? c_in[j * 1024 + k] : cctx_in[k]; sil[i] = cv / (1.f + expf(-cv)); }
        __syncthreads();
        for (int item = bx; item < DEPTH * 48; item += G) {
            const int l = item / 48, cb = item % 48;
            const float* W = w_mod + (size_t)l * 1024 * 3072 + cb * 64 + lane;
            float a0 = 0.f, a1 = 0.f, a2 = 0.f, a3 = 0.f, a4 = 0.f, a5 = 0.f, a6 = 0.f, a7 = 0.f, a8 = 0.f;
#pragma unroll 8
            for (int kk = 0; kk < 128; ++kk) { const int k = wave * 128 + kk; const float wv = W[(size_t)k * 3072];
                a0 += sil[k] * wv; a1 += sil[1024 + k] * wv; a2 += sil[2048 + k] * wv; a3 += sil[3072 + k] * wv; a4 += sil[4096 + k] * wv;
                a5 += sil[5120 + k] * wv; a6 += sil[6144 + k] * wv; a7 += sil[7168 + k] * wv; a8 += sil[8192 + k] * wv; }
            LAS float* rw = red + wave * 9 * 64 + lane;
            rw[0] = a0; rw[64] = a1; rw[128] = a2; rw[192] = a3; rw[256] = a4; rw[320] = a5; rw[384] = a6; rw[448] = a7; rw[512] = a8;
            __syncthreads();
            for (int i = tid; i < 9 * 64; i += NWAVES * 64) { const int j = i >> 6, cc = i & 63; float s = b_mod[l * 3072 + cb * 64 + cc];
#pragma unroll
                for (int w = 0; w < 8; ++w) s += red[(w * 9 + j) * 64 + cc];
                modT[(size_t)(l * 9 + j) * 3072 + cb * 64 + cc] = s; }
            __syncthreads();
        }
    }
    SEAM(0);

    for (int l = 0; l < DEPTH; ++l) {
        const float* modl = modT + (size_t)l * 9 * 3072;
        const bool need_ctx = l < DEPTH - 1;
        if (IN_PH(1 + 4 * l)) {
            OPAQUE_TID();
            for (int row = gw; row < MT; row += NGW) {
                const bool isc = row >= MX; const int rr = isc ? row - MX : row;
                const float* src = (l == 0) ? (isc ? ctx_in : x_in) : (isc ? XRc : XRx);
                float* dst = isc ? XRc : XRx;
                const GAS f32x4* xr = (const GAS f32x4*)(src + (size_t)rr * 1024) + lane;
                f32x4 v[4];
#pragma unroll
                for (int j = 0; j < 4; ++j) v[j] = xr[64 * j];
                if (l > 0) {
                    float s = 0.f;
#pragma unroll
                    for (int j = 0; j < 4; ++j) s += (v[j].x + v[j].y) + (v[j].z + v[j].w);
                    const float mean = wave_sum(s) * (1.f / 1024.f); float s2 = 0.f;
#pragma unroll
                    for (int j = 0; j < 4; ++j) { v[j] = v[j] - mean; s2 += (v[j].x * v[j].x + v[j].y * v[j].y) + (v[j].z * v[j].z + v[j].w * v[j].w); }
                    const float rstd = 1.f / sqrtf(wave_sum(s2) * (1.f / 1024.f) + LN_EPS);
                    GAS f32x4* xo = (GAS f32x4*)(dst + (size_t)rr * 1024) + lane;
#pragma unroll
                    for (int j = 0; j < 4; ++j) { const f32x4 g4 = *((const f32x4*)(ln_g + (l - 1) * 1024) + lane + 64 * j), b4 = *((const f32x4*)(ln_b + (l - 1) * 1024) + lane + 64 * j);
                        v[j] = v[j] * rstd * g4 + b4; xo[64 * j] = v[j]; }
                }
                const float* mrow = modl + (isc ? 8 : (row >> 12)) * 3072;
                GAS v2u* o8 = (GAS v2u*)(XN + (size_t)row * 1024) + lane;
#pragma unroll
                for (int j = 0; j < 4; ++j) { const f32x4 sh = *((const f32x4*)mrow + lane + 64 * j), sc = *((const f32x4*)(mrow + 1024) + lane + 64 * j);
                    const f32x4 h = v[j] * (sc + 1.f) + sh; v2u w; w.x = cvtpk(h.x, h.y); w.y = cvtpk(h.z, h.w); o8[64 * j] = w; }
            }
        }
        SEAM(1 + 4 * l);
        if (IN_PH(2 + 4 * l)) {
            pg8::Gemm g{XN, Win_t + (size_t)l * 4096 * 1024, MT, 4096, 1024}; pg8::StaticOrder S; S.init(MT, 4096, G, bx);
            pg8::EpiIn E{Qb, ACT / 2, l & 1, cosT, sinT};
            pg8::gemm_phase<pg8::EpiIn, pg8::StaticOrder, true, true>(lds, g, S, E);
        }
        SEAM(2 + 4 * l);
        if (IN_PH(3 + 4 * l)) {
            OPAQUE_TID();
#ifndef NO_NA
            if ((l & 1) == 0) {
                LAS float* rpbL = (LAS float*)(lds + 65536);
                const float* rpb = na_rpb + (size_t)(l >> 1) * 16 * 15 * 31;
                constexpr int NXU = NB * 16 * 16; const int per = (NXU + G - 1) / G;
                int hl = -1;
                for (int i = 0; i < per; ++i) { const int u = vcu * per + i; if (u >= NXU) break;
                    const int bh = u >> 4, rq = u & 15, b = bh >> 4, h = bh & 15, rlo = 4 * rq;
                    const int kr0 = clampi(rlo - 4, 0, 56), n1 = clampi(rlo - 1, 0, 56) + 8 - kr0;
                    if (h != hl) { for (int q = tid; q < 15 * 31; q += NWAVES * 64) rpbL[q] = rpb[h * 465 + q] * LOG2E; hl = h; }
                    attn_unit<1, 2, true, false>(lds, Qb, Kb, Vb, Zb, YZ, b * SEQ + rlo * 64, h * 64, h * 64, b * SEQ + kr0 * 64, n1, MX + b * CTXL, 4, kr0, true, rlo, rpbL, 0.f, 0.f, nullptr);
                }
                if (need_ctx) for (int u = vcu; u < NB * 16; u += G) { const int b = u >> 4, h = u & 15;
                    attn_unit<1, 2, true, false>(lds, Qb, Kb, Vb, Zb, YZ, MX + b * CTXL, h * 64, h * 64, 0, 0, MX + b * CTXL, 4, 0, false, 0, rpbL, 0.f, 0.f, nullptr); }
            }
#endif
#ifndef NO_DIFF
            if ((l & 1) == 1) {
                const float li = (l == 1) ? 0.35550906759096934f : 0.5560582041556406f;
                const float* lp = diff_lambda + (size_t)(l >> 1) * 256;
                const float sa = wave_sum(lp[lane] * lp[64 + lane]), sb = wave_sum(lp[128 + lane] * lp[192 + lane]);
                const float lam = expf(sa) - expf(sb) + li;
                const float* subg = diff_subln + (size_t)(l >> 1) * 128;
                constexpr int NXU = NB * 8 * 32; const int per = (NXU + G - 1) / G;
                for (int i = 0; i < per; ++i) { const int u = vcu * per + i; if (u >= NXU) break;
                    const int bh = u >> 5, qb = u & 31, b = bh >> 3, h = bh & 7;
                    attn_unit<1, 4, false, true>(lds, Qb, Kb, Vb, Zb, YZ, b * SEQ + qb * 128, h * 128, h * 128, b * SEQ, 64, MX + b * CTXL, 4, 0, true, 0, nullptr, lam, 1.f - li, subg);
                }
                if (need_ctx) for (int u = vcu; u < NB * 8 * 2; u += G) { const int b = u >> 4, h = (u >> 1) & 7, qh = u & 1;
                    attn_unit<1, 4, false, true>(lds, Qb, Kb, Vb, Zb, YZ, MX + b * CTXL + qh * 128, h * 128, h * 128, 0, 0, MX + b * CTXL, 4, 0, false, 0, nullptr, lam, 1.f - li, subg); }
            }
#endif
        }
        SEAM(3 + 4 * l);
        if (IN_PH(4 + 4 * l)) {
            const int Mo = need_ctx ? MT : MX;
            pg8::Gemm g{YZ, Wout_t + (size_t)l * 1024 * 1024, Mo, 1024, 1024}; pg8::StaticOrder S; S.init(Mo, 1024, G, bx);
            pg8::EpiOut E{l == 0 ? x_in : XRx, l == 0 ? ctx_in : XRc, XRx, XRc, modl};
            pg8::gemm_phase<pg8::EpiOut, pg8::StaticOrder, true, true>(lds, g, S, E);
        }
        SEAM(4 + 4 * l);
    }
    if (IN_PH(NPH - 1)) {
        OPAQUE_TID();
        for (int row = gw; row < MX; row += NGW) {
            GAS f32x4* xr = (GAS f32x4*)(XRx + (size_t)row * 1024) + lane;
            f32x4 v[4]; float s = 0.f;
#pragma unroll
            for (int j = 0; j < 4; ++j) { v[j] = xr[64 * j]; s += (v[j].x + v[j].y) + (v[j].z + v[j].w); }
            const float mean = wave_sum(s) * (1.f / 1024.f); float s2 = 0.f;
#pragma unroll
            for (int j = 0; j < 4; ++j) { v[j] = v[j] - mean; s2 += (v[j].x * v[j].x + v[j].y * v[j].y) + (v[j].z * v[j].z + v[j].w * v[j].w); }
            const float rstd = 1.f / sqrtf(wave_sum(s2) * (1.f / 1024.f) + LN_EPS);
#pragma unroll
            for (int j = 0; j < 4; ++j) { const f32x4 g4 = *((const f32x4*)(ln_g + 3 * 1024) + lane + 64 * j), b4 = *((const f32x4*)(ln_b + 3 * 1024) + lane + 64 * j);
                xr[64 * j] = v[j] * rstd * g4 + b4; }
        }
    }
#undef IN_PH
#undef SEAM
}

#ifndef N_LAUNCH_MODE
#define N_LAUNCH_MODE 1
#endif
extern "C" void kernel_launch(void* const* d_in, const int* in_sizes, int n_in, void* d_out, int out_size, void* d_ws, size_t ws_size, hipStream_t stream) {
    static int grid = 0;
    if (grid == 0) {
        if (n_in != 13 || out_size != MX * DM || ws_size < WS_END) { fprintf(stderr, "kernel_launch: unexpected shapes (n_in %d out %d ws %zu)\n", n_in, out_size, ws_size); grid = -1; return; }
        int dev = 0, cus = 0, per_cu = 0;
        hipGetDevice(&dev); hipDeviceGetAttribute(&cus, hipDeviceAttributeMultiprocessorCount, dev);
        if (hipFuncSetAttribute((const void*)fwd_kernel, hipFuncAttributeMaxDynamicSharedMemorySize, LDS_BYTES) != hipSuccess) { fprintf(stderr, "kernel_launch: hipFuncSetAttribute failed\n"); grid = -1; return; }
        if (hipOccupancyMaxActiveBlocksPerMultiprocessor(&per_cu, (const void*)fwd_kernel, NWAVES * 64, LDS_BYTES) != hipSuccess || per_cu < 1) { fprintf(stderr, "kernel_launch: occupancy query gave %d\n", per_cu); per_cu = 1; }
        (void)hipGetLastError();
        grid = cus * 1;
        if (grid <= 0) grid = 256;
    }
    if (grid < 0) return;
    Args a{};
    for (int i = 0; i < 13; ++i) a.in[i] = (const float*)d_in[i];
    a.out = (float*)d_out; a.ws = (unsigned char*)d_ws;
#if N_LAUNCH_MODE == 1
    a.ph_lo = 0; a.ph_hi = NPH;
    void* kargs[] = {&a};
    hipError_t e = hipLaunchCooperativeKernel((const void*)fwd_kernel, dim3(grid), dim3(NWAVES * 64), kargs, LDS_BYTES, stream);
    if (e != hipSuccess) fprintf(stderr, "cooperative launch failed: %s (grid %d)\n", hipGetErrorString(e), grid);
#else
    for (int p = 0; p < NPH; ++p) { a.ph_lo = p; a.ph_hi = p + 1; hipLaunchKernelGGL(fwd_kernel, dim3(grid), dim3(NWAVES * 64), LDS_BYTES, stream, a); }
#endif
}
```

```cpp
#include <hip/hip_runtime.h>
#include <hip/hip_cooperative_groups.h>
#include <cstdio>
#include <cstdint>
namespace cg = cooperative_groups;
#ifndef REP_P0
#define REP_P0 1
#endif
#ifndef REP_A
#define REP_A 1
#endif
#ifndef REP_D
#define REP_D 1
#endif
#ifndef REP_B
#define REP_B 1
#endif
#ifndef REP_NA
#define REP_NA 1
#endif
#ifndef REP_DIFF
#define REP_DIFF 1
#endif
#ifndef PROBE_NA
#define PROBE_NA 0
#endif
#ifndef PROBE_DIFF
#define PROBE_DIFF 0
#endif
__device__ __forceinline__ int lane_id_v() { int l; asm volatile("v_mbcnt_lo_u32_b32 %0, -1, 0\n\tv_mbcnt_hi_u32_b32 %0, -1, %0" : "=v"(l)); return l; }
#define N_LAUNCH_MODE 1
namespace pg8 {
#define PG8_LAS __attribute__((address_space(3)))
typedef unsigned short bf16_t;
typedef short bf16x8 __attribute__((ext_vector_type(8)));
typedef float f32x4 __attribute__((ext_vector_type(4)));
typedef unsigned u32x4 __attribute__((ext_vector_type(4)));
constexpr int BM = 256, BK = 64, HALF = 128, HTB = HALF * BK * 2  , STAGE_BYTES = 8 * HTB, NXCD = 8, WGM = 8;

__host__ __device__ __forceinline__ int lds_byte(int r, int c) { const int st = (r >> 4) * 2 + (c >> 5), rr = r & 15, cc = c & 31, ob = rr * 64 + cc * 2; return st * 1024 + (ob ^ (((ob >> 9) & 1) << 5)); }
__host__ __device__ __forceinline__ void stage_rc(int b, int& R, int& C) { const int st = b / 1024, sb = b % 1024, swz = sb ^ (((sb >> 9) & 1) << 5); R = (st >> 1) * 16 + swz / 64; C = (st & 1) * 32 + (swz % 64) / 2; }
__host__ __device__ __forceinline__ int perm32(int rho) { const int n = rho >> 4, i = rho & 15; return 8 * (i >> 2) + 4 * n + (i & 3); }

struct Unit { int pm, pn; };
struct Gemm { const bf16_t* A; const bf16_t* Bt; int M, N, K; };

struct StaticOrder {
    int nM, nN, nwg, G, c;
    __host__ __device__ void init(int M, int N, int G_, int c_) { nM = M / BM; nN = N / BM; nwg = nM * nN; G = G_; c = c_; }
    __host__ __device__ bool next(int i, Unit& u) const {
        const long L = (long)i * G + c; if (L >= nwg) return false;
        int wgid = (int)L; { const int q = nwg / NXCD, r = nwg % NXCD, xcd = wgid % NXCD, off = wgid / NXCD; wgid = (xcd < r ? xcd * (q + 1) : r * (q + 1) + (xcd - r) * q) + off; }
        const int nig = WGM * nN, gid = wgid / nig, fm = gid * WGM, gsz = (nM - fm) < WGM ? (nM - fm) : WGM;
        u.pm = fm + ((wgid % nig) % gsz); u.pn = (wgid % nig) / gsz; return true;
    }
    __device__ __forceinline__ void a_ready(const Unit&) const {}
    __device__ __forceinline__ void done(const Unit&) const {}
};
__device__ __forceinline__ unsigned cvt_pk_bf16(float lo, float hi) { unsigned r; asm volatile("v_cvt_pk_bf16_f32 %0, %1, %2" : "=v"(r) : "v"(lo), "v"(hi)); return r; }
template <class Epi, class Sched, bool ALIGN_EPI = false, bool SP2 = false>
__device__ __forceinline__ void gemm_phase(PG8_LAS unsigned char* lds, const Gemm g, const Sched& S, const Epi& E, const int wid_in) {
    int tid_o = wid_in * 64 + lane_id_v(); asm volatile("" : "+v"(tid_o));
    const int tid = tid_o, wid = __builtin_amdgcn_readfirstlane(tid >> 6), lane = tid & 63, wr = wid >> 2, wc = wid & 3, fr = lane & 15, fq = lane >> 4;
    const int K = g.K, nt = K / BK;
    unsigned voffA[2], voffB[2];
#pragma unroll
    for (int i = 0; i < 2; ++i) { int R, C; stage_rc(tid * 16 + i * 8192, R, C); const int Rb = Epi::PERM ? ((R & ~31) + perm32(R & 31)) : R;
        voffA[i] = (unsigned)(R * K + C) * 2u; voffB[i] = (unsigned)(Rb * K + C) * 2u; }
    const size_t kstep = (size_t)(BK * 2);
    const size_t hstep = (size_t)HALF * K * 2;
    const size_t tstep = 2 * hstep;
    const unsigned ldsw = (unsigned)wid * 1024u;
    const int aoff = lds_byte(wr * 64 + fr, fq * 8), boff = lds_byte(wc * 32 + fr, fq * 8);
#define PG8_SA(b, h) (((b) * 2 + (h)) * HTB)
#define PG8_SB(b, h) ((4 + (b) * 2 + (h)) * HTB)
#define PG8_STAGE(bufoff, gbase, voff) do { _Pragma("unroll") for (int _i = 0; _i < 2; ++_i) \
        __builtin_amdgcn_global_load_lds((const unsigned*)((const char*)(gbase) + (voff)[_i]), (PG8_LAS unsigned*)(lds + (bufoff) + ldsw + _i * 8192), 16, 0, 0); } while (0)
#define PG8_LDA(dst, b, h) do { _Pragma("unroll") for (int m = 0; m < 4; ++m) _Pragma("unroll") for (int k = 0; k < 2; ++k) dst[m][k] = *(const PG8_LAS bf16x8*)(lds + PG8_SA(b, h) + aoff + m * 2048 + k * 1024); } while (0)
#define PG8_LDB(dst, b, h) do { _Pragma("unroll") for (int n = 0; n < 2; ++n) _Pragma("unroll") for (int k = 0; k < 2; ++k) dst[n][k] = *(const PG8_LAS bf16x8*)(lds + PG8_SB(b, h) + boff + n * 2048 + k * 1024); } while (0)
#define PG8_MMA(ai, bj, At, Bt) do { __builtin_amdgcn_s_setprio(1); _Pragma("unroll") for (int m = 0; m < 4; ++m) _Pragma("unroll") for (int n = 0; n < 2; ++n) _Pragma("unroll") for (int k = 0; k < 2; ++k) \
        acc[ai][bj][m][n] = __builtin_amdgcn_mfma_f32_16x16x32_bf16(Bt[n][k], At[m][k], acc[ai][bj][m][n], 0, 0, 0); __builtin_amdgcn_s_setprio(0); } while (0)
#define PG8_WAIT_V(n) asm volatile("s_waitcnt vmcnt(" #n ")" ::: "memory")
#define PG8_WAIT_L(n) asm volatile("s_waitcnt lgkmcnt(" #n ")" ::: "memory")
#define PG8_BAR __builtin_amdgcn_s_barrier()
#define PG8_SCHED __builtin_amdgcn_sched_barrier(0)
    Unit cur, nxt; int ui = 0;
    if (!S.next(0, cur)) return;
    f32x4 acc[2][2][4][2];
#pragma unroll
    for (int a = 0; a < 2; ++a)
#pragma unroll
        for (int b = 0; b < 2; ++b)
#pragma unroll
            for (int m = 0; m < 4; ++m)
#pragma unroll
                for (int n = 0; n < 2; ++n) acc[a][b][m][n] = (f32x4){0.f, 0.f, 0.f, 0.f};
    bf16x8 At[4][2], B0[2][2], B1[2][2];
    const char* cA = (const char*)g.A + (size_t)cur.pm * tstep; const char* cB = (const char*)g.Bt + (size_t)cur.pn * tstep;
    S.a_ready(cur);
    if constexpr (SP2) {
        PG8_STAGE(PG8_SB(0, 0), cB, voffB); PG8_STAGE(PG8_SB(0, 1), cB + hstep, voffB); PG8_STAGE(PG8_SA(0, 0), cA, voffA); PG8_STAGE(PG8_SA(0, 1), cA + hstep, voffA);
        if (wr == 1) PG8_BAR;
        PG8_WAIT_V(2); PG8_BAR;
        PG8_STAGE(PG8_SB(1, 0), cB + kstep, voffB); PG8_STAGE(PG8_SA(1, 0), cA + kstep, voffA); PG8_STAGE(PG8_SB(1, 1), cB + hstep + kstep, voffB);
        PG8_WAIT_V(6); PG8_BAR;
    } else {
        PG8_STAGE(PG8_SB(0, 0), cB, voffB); PG8_STAGE(PG8_SA(0, 0), cA, voffA); PG8_STAGE(PG8_SB(0, 1), cB + hstep, voffB); PG8_STAGE(PG8_SA(0, 1), cA + hstep, voffA);
        if (wr == 1) PG8_BAR;
        PG8_WAIT_V(4); PG8_BAR;
        PG8_STAGE(PG8_SB(1, 0), cB + kstep, voffB); PG8_STAGE(PG8_SA(1, 0), cA + kstep, voffA); PG8_STAGE(PG8_SB(1, 1), cB + hstep + kstep, voffB);
        PG8_WAIT_V(6); PG8_BAR;
    }
    for (;;) {
        const bool has_next = S.next(ui + 1, nxt);
        const char* nA = has_next ? (const char*)g.A + (size_t)nxt.pm * tstep : cA; const char* nB = has_next ? (const char*)g.Bt + (size_t)nxt.pn * tstep : cB;
        for (int t = 0; t < nt; t += 2) {
            const bool last = (t == nt - 2);
            const char* a1 = cA + (size_t)(t + 1) * kstep;
            const char* a2 = last ? nA : cA + (size_t)(t + 2) * kstep; const char* b2 = last ? nB : cB + (size_t)(t + 2) * kstep;
            const char* a3 = a2 + kstep; const char* b3 = b2 + kstep;
            if (last && has_next) S.a_ready(nxt);
            if constexpr (SP2) {
            PG8_LDB(B0, 0, 0); PG8_LDB(B1, 0, 1); PG8_SCHED; PG8_LDA(At, 0, 0); PG8_STAGE(PG8_SA(1, 1), a1 + hstep, voffA);
            PG8_WAIT_V(8); PG8_WAIT_L(0); PG8_BAR; PG8_MMA(0, 0, At, B0); PG8_MMA(0, 1, At, B1); PG8_BAR; PG8_SCHED;
            PG8_LDA(At, 0, 1); PG8_STAGE(PG8_SB(0, 0), b2, voffB); PG8_STAGE(PG8_SB(0, 1), b2 + hstep, voffB); PG8_STAGE(PG8_SA(0, 0), a2, voffA);
            PG8_WAIT_V(8); PG8_WAIT_L(0); PG8_BAR; PG8_MMA(1, 0, At, B0); PG8_MMA(1, 1, At, B1); PG8_BAR; PG8_SCHED;
            PG8_LDB(B0, 1, 0); PG8_LDB(B1, 1, 1); PG8_SCHED; PG8_LDA(At, 1, 0); PG8_STAGE(PG8_SA(0, 1), a2 + hstep, voffA);
            PG8_WAIT_V(8); PG8_WAIT_L(0); PG8_BAR; PG8_MMA(0, 0, At, B0); PG8_MMA(0, 1, At, B1); PG8_BAR; PG8_SCHED;
            PG8_LDA(At, 1, 1); PG8_STAGE(PG8_SB(1, 0), b3, voffB); PG8_STAGE(PG8_SB(1, 1), b3 + hstep, voffB); PG8_STAGE(PG8_SA(1, 0), a3, voffA);
            PG8_WAIT_V(8); PG8_WAIT_L(0); PG8_BAR; PG8_MMA(1, 0, At, B0); PG8_MMA(1, 1, At, B1); PG8_BAR; PG8_SCHED;
            } else {
            PG8_LDB(B0, 0, 0); PG8_SCHED; PG8_LDA(At, 0, 0); PG8_STAGE(PG8_SA(1, 1), a1 + hstep, voffA);
            PG8_WAIT_L(8); PG8_BAR; PG8_WAIT_L(0); PG8_MMA(0, 0, At, B0); PG8_BAR; PG8_SCHED;
            PG8_LDB(B1, 0, 1); PG8_STAGE(PG8_SB(0, 0), b2, voffB);
            PG8_BAR; PG8_WAIT_L(0); PG8_MMA(0, 1, At, B1); PG8_BAR;
            PG8_LDA(At, 0, 1); PG8_STAGE(PG8_SA(0, 0), a2, voffA);
            PG8_BAR; PG8_WAIT_L(0); PG8_MMA(1, 0, At, B0); PG8_BAR; PG8_SCHED;
            PG8_STAGE(PG8_SB(0, 1), b2 + hstep, voffB);
            PG8_WAIT_V(6); PG8_BAR; PG8_MMA(1, 1, At, B1); PG8_BAR;
            PG8_LDB(B0, 1, 0); PG8_SCHED; PG8_LDA(At, 1, 0); PG8_STAGE(PG8_SA(0, 1), a2 + hstep, voffA);
            PG8_WAIT_L(8); PG8_BAR; PG8_WAIT_L(0); PG8_MMA(0, 0, At, B0); PG8_BAR; PG8_SCHED;
            PG8_LDB(B1, 1, 1); PG8_STAGE(PG8_SB(1, 0), b3, voffB);
            PG8_BAR; PG8_WAIT_L(0); PG8_MMA(0, 1, At, B1); PG8_BAR;
            PG8_LDA(At, 1, 1); PG8_STAGE(PG8_SA(1, 0), a3, voffA);
            PG8_BAR; PG8_WAIT_L(0); PG8_MMA(1, 0, At, B0); PG8_BAR; PG8_SCHED;
            PG8_STAGE(PG8_SB(1, 1), b3 + hstep, voffB);
            PG8_WAIT_V(6); PG8_BAR; PG8_MMA(1, 1, At, B1); PG8_BAR;
            }
        }
        if constexpr (ALIGN_EPI) { if (wr == 0) PG8_BAR; }
        if constexpr (!Epi::AFTER_DRAIN) { E(acc, cur, wr, wc, fr, fq); S.done(cur); }
        if (!has_next) break;
#pragma unroll
        for (int a = 0; a < 2; ++a)
#pragma unroll
            for (int b = 0; b < 2; ++b)
#pragma unroll
                for (int m = 0; m < 4; ++m)
#pragma unroll
                    for (int n = 0; n < 2; ++n) acc[a][b][m][n] = (f32x4){0.f, 0.f, 0.f, 0.f};
        cur = nxt; cA = nA; cB = nB; ++ui;
        if constexpr (ALIGN_EPI) { if (wr == 1) PG8_BAR; }
    }
    PG8_WAIT_V(0);
    if constexpr (!ALIGN_EPI) { if (wr == 0) PG8_BAR; }
    PG8_BAR;
    if constexpr (Epi::AFTER_DRAIN) { E.fused(acc, cur, wr, wc, fr, fq, lds, wid, lane); S.done(cur); }
#undef PG8_SA
#undef PG8_SB
#undef PG8_STAGE
#undef PG8_LDA
#undef PG8_LDB
#undef PG8_MMA
#undef PG8_WAIT_V
#undef PG8_WAIT_L
#undef PG8_BAR
#undef PG8_SCHED
}
}

#define GAS __attribute__((address_space(1)))
#define LAS __attribute__((address_space(3)))
typedef unsigned short bf16;
typedef unsigned v4u __attribute__((ext_vector_type(4)));
typedef unsigned v2u __attribute__((ext_vector_type(2)));
typedef float f32x4 __attribute__((ext_vector_type(4)));
typedef float f32x16 __attribute__((ext_vector_type(16)));
typedef short bf16x8 __attribute__((ext_vector_type(8)));
typedef short s16x4 __attribute__((ext_vector_type(4)));
typedef GAS unsigned gu32;
#define RLX_AGENT __ATOMIC_RELAXED, __HIP_MEMORY_SCOPE_AGENT
#define LDS_WAIT() asm volatile("s_waitcnt lgkmcnt(0)" ::: "memory")
#define VM_WAIT() asm volatile("s_waitcnt vmcnt(0)" ::: "memory")

constexpr int DM = 1024, NB = 8, SEQ = 4096, CTXL = 256, DEPTH = 4;
constexpr int MX = NB * SEQ, MC = NB * CTXL, MT = MX + MC;
constexpr float ALPHA = 1.681792830507429f;
constexpr float LN_EPS = 1e-5f;
constexpr float LOG2E = 1.4426950408889634f;
constexpr float QSCALE = 0.125f * LOG2E;
constexpr int NWAVES = 8;
constexpr int NPH = 2 + 4 * DEPTH;

constexpr size_t MiB = 1u << 20;
constexpr size_t WS_CTL = 0, CTL_ZERO_BYTES = 64 * 1024;
constexpr int CW_BAR = 1024, CW_SUB = 8192;
constexpr size_t WS_MOD = 1 * MiB;
constexpr size_t WS_COS = 1 * MiB + 512 * 1024, WS_SIN = WS_COS + 4096;
constexpr size_t WS_STATS = 1 * MiB + 640 * 1024;
constexpr size_t WS_WIN = 2 * MiB;
constexpr size_t WS_WOUT = 34 * MiB;
constexpr size_t WS_XRC = 42 * MiB;
constexpr size_t WS_XN = 50 * MiB;
constexpr size_t ACT = (size_t)68 * MiB;
constexpr size_t WS_Q = 118 * MiB, WS_K = WS_Q + ACT, WS_V = WS_K + ACT, WS_Z = WS_V + ACT, WS_YZ = WS_Z + ACT, WS_END = WS_YZ + ACT;
constexpr int NAB_TINT = 65536, NAB_TB = NAB_TINT + 16 * 512, NAB_RPB = NAB_TB + 15 * 16 * 256 + 512;
constexpr int LDS_BYTES = 147456;

__device__ __forceinline__ unsigned f2bf(float f) { unsigned u = __builtin_bit_cast(unsigned, f); return (u + 0x7fffu + ((u >> 16) & 1u)) >> 16; }
__device__ __forceinline__ unsigned pk2(float lo, float hi) { return f2bf(lo) | (f2bf(hi) << 16); }
typedef float f32x2_t __attribute__((ext_vector_type(2))); typedef __bf16 bf16x2_t __attribute__((ext_vector_type(2)));
__device__ __forceinline__ unsigned cvtpk(float lo, float hi) { f32x2_t v = {lo, hi}; bf16x2_t b = __builtin_convertvector(v, bf16x2_t); return __builtin_bit_cast(unsigned, b); }
__device__ __forceinline__ float bflo(unsigned u) { return __builtin_bit_cast(float, u << 16); }
__device__ __forceinline__ float bfhi(unsigned u) { return __builtin_bit_cast(float, u & 0xffff0000u); }
__device__ __forceinline__ float wave_sum(float v) {
#pragma unroll
    for (int o = 1; o < 64; o <<= 1) v += __shfl_xor(v, o);
    return v;
}
__device__ __forceinline__ float silu_f(float v) { return v * __builtin_amdgcn_rcpf(1.f + __builtin_amdgcn_exp2f(-1.4426950408889634f * v)); }

namespace pg8 {
struct EpiIn {
    static constexpr bool PERM = true, AFTER_DRAIN = false;
    bf16_t* Q; size_t stride; int rope; const float* cosT; const float* sinT;
    __device__ __forceinline__ void operator()(const f32x4 (&acc)[2][2][4][2], const Unit& u, int wr, int wc, int fr, int fq) const {
        const int t = u.pn >> 2, colt = (u.pn & 3) * 256;
        bf16_t* base = Q + (size_t)t * stride;
        const int row0 = u.pm * BM + wr * 64 + fr, col0 = colt + wc * 32 + 8 * fq;
        const bool do_rope = rope && t < 2 && u.pm < (MX / BM);
        const int half = wc & 1, f0 = 8 * (fq & 1);
        const float sgn = (fq >> 1) ? 1.f : -1.f;
#pragma unroll
        for (int ai = 0; ai < 2; ++ai)
#pragma unroll
            for (int m = 0; m < 4; ++m) {
                const int row = row0 + ai * HALF + m * 16;
                bf16_t* rowp = (t == 3) ? base + (size_t)row * 1024 + col0 : base + ((size_t)(col0 >> 6) * MT + row) * 64 + (col0 & 63);
                f32x4 c0 = {1.f, 1.f, 1.f, 1.f}, c1 = c0, s0 = {0.f, 0.f, 0.f, 0.f}, s1 = s0;
                if (do_rope) { const int tok = row & (SEQ - 1); const int pos = half ? (tok & 63) : (tok >> 6);
                    c0 = *(const f32x4*)(cosT + pos * 16 + f0); c1 = *(const f32x4*)(cosT + pos * 16 + f0 + 4);
                    s0 = *(const f32x4*)(sinT + pos * 16 + f0) * sgn; s1 = *(const f32x4*)(sinT + pos * 16 + f0 + 4) * sgn; }
#pragma unroll
                for (int bj = 0; bj < 2; ++bj) {
                    f32x4 v0 = acc[ai][bj][m][0], v1 = acc[ai][bj][m][1];
                    if (t == 3) {
#pragma unroll
                        for (int j = 0; j < 4; ++j) { v0[j] = silu_f(v0[j]); v1[j] = silu_f(v1[j]); }
                    } else if (do_rope) {
                        f32x4 p0, p1;
#pragma unroll
                        for (int j = 0; j < 4; ++j) { p0[j] = __shfl_xor(v0[j], 32); p1[j] = __shfl_xor(v1[j], 32); }
                        v0 = v0 * c0 + p0 * s0; v1 = v1 * c1 + p1 * s1;
                    }
                    if (t == 0) { v0 = v0 * QSCALE; v1 = v1 * QSCALE; }
                    u32x4 w; w.x = cvt_pk_bf16(v0[0], v0[1]); w.y = cvt_pk_bf16(v0[2], v0[3]); w.z = cvt_pk_bf16(v1[0], v1[1]); w.w = cvt_pk_bf16(v1[2], v1[3]);
                    *(u32x4*)(rowp + (t == 3 ? bj * HALF : bj * 2 * MT * 64)) = w;
                }
            }
    }
};
struct EpiOut {
    static constexpr bool PERM = false, AFTER_DRAIN = false;
    const float* res_x; const float* res_c; float* out_x; float* out_c; const float* modl;
    const float* stats; const float* lng; const float* lnb;
    __device__ __forceinline__ void operator()(const f32x4 (&acc)[2][2][4][2], const Unit& u, int wr, int wc, int fr, int fq) const {
        const bool isc = u.pm >= (MX / BM);
        const int rbase = (isc ? u.pm - MX / BM : u.pm) * BM + wr * 64 + fr;
        const float* res = isc ? res_c : res_x; float* out = isc ? out_c : out_x;
        const int bidx = isc ? 8 : (u.pm >> 4);
        const int col0 = u.pn * BM + wc * 32 + 4 * fq;
        const float* g = modl + bidx * 3072 + 2048 + col0;
        f32x4 gv[2][2], lg[2][2], lb[2][2];
#pragma unroll
        for (int bj = 0; bj < 2; ++bj)
#pragma unroll
            for (int n = 0; n < 2; ++n) { gv[bj][n] = *(const f32x4*)(g + bj * HALF + n * 16) + 1.f;
                if (stats) { lg[bj][n] = *(const f32x4*)(lng + col0 + bj * HALF + n * 16) * ALPHA; lb[bj][n] = *(const f32x4*)(lnb + col0 + bj * HALF + n * 16) * ALPHA; }
                else { lg[bj][n] = (f32x4){ALPHA, ALPHA, ALPHA, ALPHA}; lb[bj][n] = (f32x4){0.f, 0.f, 0.f, 0.f}; } }
        const int srow0 = (isc ? MX : 0) + rbase;
#pragma unroll
        for (int ai = 0; ai < 2; ++ai)
#pragma unroll
            for (int m = 0; m < 4; ++m) { const int rr = rbase + ai * HALF + m * 16; const size_t off = (size_t)rr * 1024 + col0;
                float mean = 0.f, rstd = 1.f;
                if (stats) { const float* sp = stats + 2 * (size_t)(srow0 + ai * HALF + m * 16); mean = sp[0]; rstd = sp[1]; }
#pragma unroll
                for (int bj = 0; bj < 2; ++bj)
#pragma unroll
                    for (int n = 0; n < 2; ++n) { const f32x4 r4 = *(const f32x4*)(res + off + bj * HALF + n * 16);
                        *(f32x4*)(out + off + bj * HALF + n * 16) = ((r4 - mean) * rstd) * lg[bj][n] + lb[bj][n] + gv[bj][n] * acc[ai][bj][m][n]; }
                if (m & 1) asm volatile("" ::: "memory"); }
    }
};
}

#define MFMA32(a, b, c) __builtin_amdgcn_mfma_f32_32x32x16_bf16((a), (b), (c), 0, 0, 0)
typedef short v4i16_t __attribute__((ext_vector_type(4)));
__device__ __forceinline__ s16x4 vtr(const LAS unsigned char* p) { return __builtin_bit_cast(s16x4, __builtin_amdgcn_ds_read_tr16_b64_v4i16((LAS v4i16_t*)p)); }
__device__ __forceinline__ int crow(int r, int hi) { return (r & 3) + 8 * (r >> 2) + 4 * hi; }
__device__ __forceinline__ int clampi(int v, int lo, int hi) { return v < lo ? lo : (v > hi ? hi : v); }

__device__ __forceinline__ float max3f(float a, float b, float c) { float r; asm("v_max3_f32 %0, %1, %2, %3" : "=v"(r) : "v"(a), "v"(b), "v"(c)); return r; }
__device__ __forceinline__ void glds16(const void* gbase, unsigned voff_bytes, unsigned lds_dst) { unsigned keep;
    asm volatile("s_mov_b32 %0, m0\n\ts_mov_b32 m0, %3\n\ts_nop 0\n\tglobal_load_lds_dwordx4 %1, %2\n\ts_mov_b32 m0, %0" : "=&s"(keep) : "v"(voff_bytes), "s"(gbase), "s"(lds_dst) : "memory"); }
#define ATT_WAITBAR(N) asm volatile("s_waitcnt vmcnt(" #N ") lgkmcnt(0)\n\ts_barrier" ::: "memory")
template <int DVB, bool NA, bool SPLIT>
__device__ __forceinline__ void attn_unit(const int PROBE, const int wid_in, LAS unsigned char* lds, const bf16* Q, const bf16* Km, const bf16* Vm, const bf16* SZ, bf16* YZ,
                                          int q_row0, int qcol, int vcol, int seg1, int n1, int seg2, int n2, int kr0, bool xunit, int rq0,
                                          const LAS float* rpbL, float lam, float omli, const float* subg) {
    constexpr int KMAPS = SPLIT ? 2 : 1, KB = 8192, STAGE = KMAPS * KB + DVB * 4096, NS = 4, IPT = KMAPS + DVB / 2;
    static_assert(IPT == 2 || IPT == 4, "DMA instructions per tile per thread");
    int tid_o = wid_in * 64 + lane_id_v(); asm volatile("" : "+v"(tid_o));
    const int tid = tid_o, lane = tid & 63, wid = wid_in, r32 = lane & 31, hi = lane >> 5;
    const int NT = n1 + n2;
    const int wq_off = SPLIT ? (wid & 3) * 32 : wid * 32, wmap = SPLIT ? (wid >> 2) : 0;
    const unsigned lds0 = (unsigned)(uintptr_t)lds;
    const unsigned koff = (unsigned)((wid * 8 + (lane >> 3)) * 64 + (((lane & 7) ^ ((4 * (wid & 1) + (lane >> 4)) & 7)) * 8));
    unsigned voff[DVB / 2];
#pragma unroll
    for (int i = 0; i < DVB / 2; ++i) { const int p = wid + 8 * i, dvb = p >> 2, g8 = 2 * (p & 3) + (lane >> 5), row = g8 * 8 + ((lane & 31) >> 2);
        voff[i] = (unsigned)(((size_t)0 + (dvb >> 1)) * MT * 64 + row * 64 + (dvb & 1) * 32 + (lane & 3) * 8); }
#define ATT_ISSUE(t, slot) do { if (PROBE == 1) break; const int rb_ = (t) < n1 ? seg1 + 64 * (t) : seg2 + 64 * ((t) - n1); const unsigned sb_ = lds0 + (slot) * STAGE + wid * 1024; \
        _Pragma("unroll") for (int m_ = 0; m_ < KMAPS; ++m_) glds16(Km + ((size_t)((qcol >> 6) + m_) * MT + rb_) * 64, koff * 2u, (unsigned)__builtin_amdgcn_readfirstlane(sb_ + m_ * KB)); \
        _Pragma("unroll") for (int i_ = 0; i_ < DVB / 2; ++i_) glds16(Vm + ((size_t)(vcol >> 6) * MT + rb_) * 64, voff[i_] * 2u, (unsigned)__builtin_amdgcn_readfirstlane(sb_ + KMAPS * KB + i_ * 8192)); } while (0)
#pragma unroll
    for (int t = 0; t < 2; ++t) if (t < NT) ATT_ISSUE(t, t);
    bf16x8 qf[4];
#define ATT_QROW(j) ((NA && xunit) ? (q_row0 + ((wid >> 2) * 2 + ((j) >> 4)) * 64 + (wid & 3) * 16 + ((j) & 15)) : (q_row0 + wq_off + (j)))
    { const bf16* qp = Q + ((size_t)((qcol >> 6) + wmap) * MT + ATT_QROW(r32)) * 64 + hi * 8;
#pragma unroll
      for (int d0 = 0; d0 < 4; ++d0) qf[d0] = *(const bf16x8*)(qp + d0 * 16); }
    asm volatile("" : "+v"(qf[0]), "+v"(qf[1]), "+v"(qf[2]), "+v"(qf[3]));
    float mrun = 0.f; f32x16 o[DVB], ol, negm;
    bool seen = false;
    bool pend = false;
#pragma unroll
    for (int d = 0; d < DVB; ++d)
#pragma unroll
        for (int r = 0; r < 16; ++r) o[d][r] = 0.f;
#pragma unroll
    for (int r = 0; r < 16; ++r) { ol[r] = 0.f; negm[r] = 0.f; }
    const bf16x8 ones = {0x3f80, 0x3f80, 0x3f80, 0x3f80, 0x3f80, 0x3f80, 0x3f80, 0x3f80};
    const int rowA = rq0 + 2 * (wid >> 2), row_l = rowA + (r32 >> 4), r0_l = clampi(row_l - 4, 0, 56);
    const int r0A = clampi(rowA - 4, 0, 56), r0B = clampi(rowA - 3, 0, 56);
    const int wq = 16 * (wid & 3) + (r32 & 15);
    const int cbk = (wid & 3) == 0 ? 0 : ((wid & 3) == 1 ? 8 : ((wid & 3) == 2 ? 24 : 32));
    const bool nab_int = (wq >= 8 && wq <= 56);
    const int nab_v = wq < 8 ? wq : wq - 49;
    const int nab_base = nab_int ? (NAB_TINT + (cbk + 4 * hi - wq + 63) * 4) : (NAB_TB + nab_v * (16 * 256) + (cbk + 4 * hi) * 4);
    const int nab_stride = nab_int ? 512 : 256;
    const int kbyteW = (cbk + r32) * 128, kxW = ((cbk + r32) >> 1) & 7;
    const int kbyte = r32 * 128, kx = (r32 >> 1) & 7;
    const int vlane = (4 * hi + ((lane & 15) >> 2)) * 64 + ((lane >> 4) & 1) * 32 + (lane & 3) * 8;
    constexpr int DH = DVB / 2;
    const f32x16 zero16 = {0.f, 0.f, 0.f, 0.f, 0.f, 0.f, 0.f, 0.f, 0.f, 0.f, 0.f, 0.f, 0.f, 0.f, 0.f, 0.f};
    v4u pw[4];
#pragma unroll
    for (int j = 0; j < 4; ++j) pw[j] = (v4u){0u, 0u, 0u, 0u};
#define ATT_VREAD(vfa, dlo, dhi, vbp) do { _Pragma("unroll") for (int d_ = (dlo); d_ < (dhi); ++d_) _Pragma("unroll") for (int ks_ = 0; ks_ < 4; ++ks_) { \
        const s16x4 lo_ = vtr((vbp) + (d_ * 8 + 2 * ks_) * 512), h4_ = vtr((vbp) + (d_ * 8 + 2 * ks_ + 1) * 512); \
        vfa[d_][ks_] = (bf16x8){lo_[0], lo_[1], lo_[2], lo_[3], h4_[0], h4_[1], h4_[2], h4_[3]}; } } while (0)
#define ATT_PV2(vfa, dlo, dhi) do { _Pragma("unroll") for (int d_ = (dlo); d_ < (dhi); ++d_) _Pragma("unroll") for (int ks_ = 0; ks_ < 4; ++ks_) o[d_] = MFMA32(vfa[d_][ks_], __builtin_bit_cast(bf16x8, pw[ks_]), o[d_]); } while (0)
#define ATT_SB() __builtin_amdgcn_sched_barrier(0)
    for (int t = 0; t < NT; ++t) {
        if (NA) {
            if ((t & 1) == 0) { ATT_WAITBAR(0);
                if (t + 2 < NT) ATT_ISSUE(t + 2, (t + 2) & (NS - 1));
                if (t + 3 < NT) ATT_ISSUE(t + 3, (t + 3) & (NS - 1)); }
        } else {
        { const int rem = NT - 1 - t;
          if (IPT == 4) { if (rem >= 1) ATT_WAITBAR(4); else ATT_WAITBAR(0); }
          else          { if (rem >= 1) ATT_WAITBAR(2); else ATT_WAITBAR(0); } }
        if (t + 2 < NT) ATT_ISSUE(t + 2, (t + 2) & (NS - 1));
        }
        const bool win = NA && xunit && t < n1;
        const int kr = kr0 + t;
        const bool active = (PROBE != 2) && (!win || (kr >= r0A && kr <= r0B + 7));
        if (NA && win && active) {
            const LAS unsigned char* sb = lds + (t & (NS - 1)) * STAGE;
            const LAS unsigned char* vbw = sb + KMAPS * KB + vlane + (cbk >> 3) * 512;
            const int trow = (kr >= r0_l && kr <= r0_l + 7) ? kr - row_l + 8 : 0;
            const LAS unsigned char* tb = lds + nab_base + trow * nab_stride;
            f32x16 cbv; bf16x8 kaw[4], vfw[DVB][2];
#pragma unroll
            for (int r = 0; r < 16; ++r) cbv[r] = *(const LAS float*)(tb + 4 * ((r & 3) + 8 * (r >> 2)));
#pragma unroll
            for (int d0 = 0; d0 < 4; ++d0) kaw[d0] = *(const LAS bf16x8*)(sb + kbyteW + (((2 * d0 + hi) ^ kxW) * 16));
            ATT_SB();
#pragma unroll
            for (int d = 0; d < DVB; ++d)
#pragma unroll
                for (int ks = 0; ks < 2; ++ks) { const s16x4 lo_ = vtr(vbw + (d * 8 + 2 * ks) * 512), h4_ = vtr(vbw + (d * 8 + 2 * ks + 1) * 512);
                    vfw[d][ks] = (bf16x8){lo_[0], lo_[1], lo_[2], lo_[3], h4_[0], h4_[1], h4_[2], h4_[3]}; }
            ATT_SB();
            f32x16 s0 = MFMA32(kaw[0], qf[0], cbv);
#pragma unroll
            for (int d0 = 1; d0 < 4; ++d0) s0 = MFMA32(kaw[d0], qf[d0], s0);
            ATT_SB();
#pragma unroll
            for (int r = 0; r < 16; ++r) s0[r] -= mrun;
            float mx;
            { const float t0 = max3f(s0[0], s0[1], s0[2]), t1 = max3f(s0[3], s0[4], s0[5]), t2 = max3f(s0[6], s0[7], s0[8]), t3 = max3f(s0[9], s0[10], s0[11]), t4 = max3f(s0[12], s0[13], s0[14]);
              mx = max3f(max3f(t0, t1, t2), max3f(t3, t4, s0[15]), -3e38f); }
            mx = fmaxf(mx, __shfl_xor(mx, 32));
            const bool live = mx > -1e29f;
            if (__builtin_amdgcn_ballot_w64((live && !seen) || mx > 8.f) != 0ull) {
                const float dl = seen ? fmaxf(mx, 0.f) : (live ? mx : 0.f), al = seen ? __builtin_amdgcn_exp2f(-dl) : 0.f;
                mrun += dl; seen = seen || live;
#pragma unroll
                for (int r = 0; r < 16; ++r) { s0[r] -= dl; negm[r] = -mrun; ol[r] *= al; }
#pragma unroll
                for (int d = 0; d < DVB; ++d)
#pragma unroll
                    for (int r = 0; r < 16; ++r) o[d][r] *= al;
            }
#pragma unroll
            for (int r = 0; r < 16; ++r) s0[r] = __builtin_amdgcn_exp2f(s0[r]);
#pragma unroll
            for (int j = 0; j < 4; ++j) { pw[0][j] = cvtpk(s0[2 * j], s0[2 * j + 1]); pw[1][j] = cvtpk(s0[8 + 2 * j], s0[8 + 2 * j + 1]); }
            ATT_SB();
#pragma unroll
            for (int d = 0; d < DVB; ++d)
#pragma unroll
                for (int ks = 0; ks < 2; ++ks) o[d] = MFMA32(vfw[d][ks], __builtin_bit_cast(bf16x8, pw[ks]), o[d]);
#pragma unroll
            for (int ks = 0; ks < 2; ++ks) ol = MFMA32(ones, __builtin_bit_cast(bf16x8, pw[ks]), ol);
        } else if (!NA && active) {
            const LAS unsigned char* sb = lds + (t & (NS - 1)) * STAGE;
            const LAS unsigned char* kb_ = sb + wmap * KB + kbyte;
            const LAS unsigned char* vbp = lds + ((t ? t - 1 : 0) & (NS - 1)) * STAGE + KMAPS * KB + vlane;
            bf16x8 ka[4], kc[4], vf[DVB][4];
#pragma unroll
            for (int d0 = 0; d0 < 4; ++d0) { const int ch = ((2 * d0 + hi) ^ kx) * 16;
                ka[d0] = *(const LAS bf16x8*)(kb_ + ch); kc[d0] = *(const LAS bf16x8*)(kb_ + 4096 + ch); }
            ATT_SB();
            ATT_VREAD(vf, 0, DH, vbp);
            ATT_SB();
            f32x16 s0 = MFMA32(ka[0], qf[0], zero16), s1 = MFMA32(kc[0], qf[0], zero16);
#pragma unroll
            for (int d0 = 1; d0 < 4; ++d0) { s0 = MFMA32(ka[d0], qf[d0], s0); s1 = MFMA32(kc[d0], qf[d0], s1); }
            ATT_SB();
            float mx;
            { float t0 = max3f(s0[0], s0[1], s0[2]), t1 = max3f(s0[3], s0[4], s0[5]), t2 = max3f(s0[6], s0[7], s0[8]), t3 = max3f(s0[9], s0[10], s0[11]), t4 = max3f(s0[12], s0[13], s0[14]);
              float u0 = max3f(s1[0], s1[1], s1[2]), u1 = max3f(s1[3], s1[4], s1[5]), u2 = max3f(s1[6], s1[7], s1[8]), u3 = max3f(s1[9], s1[10], s1[11]), u4 = max3f(s1[12], s1[13], s1[14]);
              t0 = max3f(t0, t1, t2); t3 = max3f(t3, t4, s0[15]); u0 = max3f(u0, u1, u2); u3 = max3f(u3, u4, s1[15]);
              mx = fmaxf(max3f(t0, t3, u0), u3); }
            mx = fmaxf(mx, __shfl_xor(mx, 32));
            if (__builtin_amdgcn_ballot_w64(!seen || mx > mrun + 8.f) != 0ull) {
                { bf16x8 vfz[DVB][4]; ATT_VREAD(vfz, 0, DVB, vbp); ATT_PV2(vfz, 0, DVB);
#pragma unroll
                    for (int ks = 0; ks < 4; ++ks) ol = MFMA32(ones, __builtin_bit_cast(bf16x8, pw[ks]), ol);
#pragma unroll
                    for (int j = 0; j < 4; ++j) pw[j] = (v4u){0u, 0u, 0u, 0u}; }
                const float mn = seen ? fmaxf(mrun, mx) : mx, al = seen ? __builtin_amdgcn_exp2f(mrun - mn) : 0.f;
                mrun = mn; seen = true;
#pragma unroll
                for (int r = 0; r < 16; ++r) ol[r] *= al;
#pragma unroll
                for (int d = 0; d < DVB; ++d)
#pragma unroll
                    for (int r = 0; r < 16; ++r) o[d][r] *= al;
            }
            ATT_SB();
            v4u pwn[4];
            {
                ATT_VREAD(vf, DH, DVB, vbp);
                ATT_PV2(vf, 0, DH);
#pragma unroll
                for (int ks = 0; ks < 4; ++ks) ol = MFMA32(ones, __builtin_bit_cast(bf16x8, pw[ks]), ol);
                ATT_PV2(vf, DH, DVB);
#pragma unroll
                for (int r = 0; r < 16; ++r) { s0[r] = __builtin_amdgcn_exp2f(s0[r] - mrun); s1[r] = __builtin_amdgcn_exp2f(s1[r] - mrun); }
#pragma unroll
                for (int j = 0; j < 4; ++j) { pwn[0][j] = cvtpk(s0[2 * j], s0[2 * j + 1]); pwn[1][j] = cvtpk(s0[8 + 2 * j], s0[8 + 2 * j + 1]);
                                              pwn[2][j] = cvtpk(s1[2 * j], s1[2 * j + 1]); pwn[3][j] = cvtpk(s1[8 + 2 * j], s1[8 + 2 * j + 1]); }
#pragma unroll
                for (int g = 0; g < 8; ++g) { __builtin_amdgcn_sched_group_barrier(0x008, 1, 0); __builtin_amdgcn_sched_group_barrier(0x100, 2, 0); __builtin_amdgcn_sched_group_barrier(0x002, 1, 0); __builtin_amdgcn_sched_group_barrier(0x400, 1, 0); }
#pragma unroll
                for (int g = 0; g < 12; ++g) { __builtin_amdgcn_sched_group_barrier(0x008, 1, 0); __builtin_amdgcn_sched_group_barrier(0x002, 3, 0); __builtin_amdgcn_sched_group_barrier(0x400, 2, 0); }
            }
            ATT_SB();
#pragma unroll
            for (int j = 0; j < 4; ++j) pw[j] = pwn[j];
            pend = true;
        } else if (active) {
            const LAS unsigned char* sb = lds + (t & (NS - 1)) * STAGE;
            const LAS unsigned char* kb_ = sb + wmap * KB + kbyte;
            const LAS unsigned char* vb_ = sb + KMAPS * KB + vlane;
            bf16x8 ka[4], kc[4], vf[DVB][4];
#pragma unroll
            for (int d0 = 0; d0 < 4; ++d0) { const int ch = ((2 * d0 + hi) ^ kx) * 16;
                ka[d0] = *(const LAS bf16x8*)(kb_ + ch); kc[d0] = *(const LAS bf16x8*)(kb_ + 4096 + ch); }
            ATT_SB();
            ATT_VREAD(vf, 0, DH, vb_);
            ATT_SB();
            f32x16 s0 = MFMA32(ka[0], qf[0], negm), s1 = MFMA32(kc[0], qf[0], negm);
#pragma unroll
            for (int d0 = 1; d0 < 4; ++d0) { s0 = MFMA32(ka[d0], qf[d0], s0); s1 = MFMA32(kc[d0], qf[d0], s1); }
            ATT_SB();
            float mx;
            { float t0 = max3f(s0[0], s0[1], s0[2]), t1 = max3f(s0[3], s0[4], s0[5]), t2 = max3f(s0[6], s0[7], s0[8]), t3 = max3f(s0[9], s0[10], s0[11]), t4 = max3f(s0[12], s0[13], s0[14]);
              float u0 = max3f(s1[0], s1[1], s1[2]), u1 = max3f(s1[3], s1[4], s1[5]), u2 = max3f(s1[6], s1[7], s1[8]), u3 = max3f(s1[9], s1[10], s1[11]), u4 = max3f(s1[12], s1[13], s1[14]);
              t0 = max3f(t0, t1, t2); t3 = max3f(t3, t4, s0[15]); u0 = max3f(u0, u1, u2); u3 = max3f(u3, u4, s1[15]);
              mx = fmaxf(max3f(t0, t3, u0), u3); }
            mx = fmaxf(mx, __shfl_xor(mx, 32));
            if (__builtin_amdgcn_ballot_w64(!seen || mx > 8.f) != 0ull) {
                const float dl = seen ? fmaxf(mx, 0.f) : mx, al = seen ? __builtin_amdgcn_exp2f(-dl) : 0.f;
                mrun += dl; seen = true;
#pragma unroll
                for (int r = 0; r < 16; ++r) { s0[r] -= dl; s1[r] -= dl; negm[r] = -mrun; ol[r] *= al; }
#pragma unroll
                for (int d = 0; d < DVB; ++d)
#pragma unroll
                    for (int r = 0; r < 16; ++r) o[d][r] *= al;
            }
#pragma unroll
            for (int r = 0; r < 16; ++r) { s0[r] = __builtin_amdgcn_exp2f(s0[r]); s1[r] = __builtin_amdgcn_exp2f(s1[r]); }
#pragma unroll
            for (int j = 0; j < 4; ++j) { pw[0][j] = cvtpk(s0[2 * j], s0[2 * j + 1]); pw[1][j] = cvtpk(s0[8 + 2 * j], s0[8 + 2 * j + 1]);
                                          pw[2][j] = cvtpk(s1[2 * j], s1[2 * j + 1]); pw[3][j] = cvtpk(s1[8 + 2 * j], s1[8 + 2 * j + 1]); }
            ATT_SB();
            ATT_VREAD(vf, DH, DVB, vb_);
            ATT_SB();
            ATT_PV2(vf, 0, DH);
#pragma unroll
            for (int ks = 0; ks < 4; ++ks) ol = MFMA32(ones, __builtin_bit_cast(bf16x8, pw[ks]), ol);
            ATT_PV2(vf, DH, DVB);
        }
    }
    if (!NA) { const LAS unsigned char* vbp = lds + ((NT - 1) & (NS - 1)) * STAGE + KMAPS * KB + vlane;
        bf16x8 vfz[DVB][4]; ATT_VREAD(vfz, 0, DVB, vbp); ATT_PV2(vfz, 0, DVB);
#pragma unroll
        for (int ks = 0; ks < 4; ++ks) ol = MFMA32(ones, __builtin_bit_cast(bf16x8, pw[ks]), ol); }
    const float lrun = ol[0];
#undef ATT_VREAD
#undef ATT_PV2
#undef ATT_SB
#undef ATT_ISSUE
    ATT_WAITBAR(0);
    if (!SPLIT) {
        const float inv = 1.f / lrun;
        LAS unsigned char* stg = lds + 2 * STAGE + wid * (32 * DVB * 64);
#pragma unroll
        for (int d = 0; d < DVB; ++d)
#pragma unroll
            for (int i = 0; i < 4; ++i) { const int ch = d * 4 + i;
                v2u w; w.x = cvtpk(o[d][4 * i] * inv, o[d][4 * i + 1] * inv); w.y = cvtpk(o[d][4 * i + 2] * inv, o[d][4 * i + 3] * inv);
                *(LAS v2u*)(stg + r32 * (DVB * 64) + ((ch ^ (r32 & (DVB * 4 - 1))) * 16) + 8 * hi) = w; }
        constexpr int CPR = DVB * 4, RPP = 64 / CPR;
#pragma unroll
        for (int p = 0; p < 32 / RPP; ++p) { const int row = p * RPP + lane / CPR, ch = lane % CPR;
            const v4u y = *(const LAS v4u*)(stg + row * (DVB * 64) + ((ch ^ (row & (CPR - 1))) * 16));
            const size_t go = (size_t)ATT_QROW(row) * 1024 + vcol + ch * 8;
            const v4u z = *(const v4u*)(SZ + go);
            v4u w; w.x = cvtpk(bflo(y.x) * bflo(z.x), bfhi(y.x) * bfhi(z.x)); w.y = cvtpk(bflo(y.y) * bflo(z.y), bfhi(y.y) * bfhi(z.y));
            w.z = cvtpk(bflo(y.z) * bflo(z.z), bfhi(y.z) * bfhi(z.z)); w.w = cvtpk(bflo(y.w) * bflo(z.w), bfhi(y.w) * bfhi(z.w));
            *(v4u*)(YZ + go) = w; }
    } else {
        LAS float* ex = (LAS float*)lds + (wid & 3) * (DVB * 16 * 64) + lane;
        const float inv = (wmap ? lam : 1.f) / lrun;
        if (wmap) {
#pragma unroll
            for (int d = 0; d < DVB; ++d)
#pragma unroll
                for (int r = 0; r < 16; ++r) ex[(d * 16 + r) * 64] = o[d][r] * inv;
        }
        __syncthreads();
        if (!wmap) {
            float ss = 0.f;
#pragma unroll
            for (int d = 0; d < DVB; ++d)
#pragma unroll
                for (int r = 0; r < 16; ++r) { const float tv = o[d][r] * inv - ex[(d * 16 + r) * 64]; o[d][r] = tv; ss += tv * tv; }
            ss += __shfl_xor(ss, 32);
            const float rn = rsqrtf(ss * (1.f / (32.f * DVB)) + LN_EPS) * omli;
            LAS unsigned char* stg = lds + 2 * STAGE + (wid & 3) * (32 * DVB * 64);
#pragma unroll
            for (int d = 0; d < DVB; ++d)
#pragma unroll
                for (int i = 0; i < 4; ++i) { const int ch = d * 4 + i, dv0 = d * 32 + 8 * i + 4 * hi;
                    const f32x4 g4 = *(const f32x4*)(subg + dv0) * rn;
                    v2u w; w.x = cvtpk(o[d][4 * i] * g4[0], o[d][4 * i + 1] * g4[1]); w.y = cvtpk(o[d][4 * i + 2] * g4[2], o[d][4 * i + 3] * g4[3]);
                    *(LAS v2u*)(stg + r32 * (DVB * 64) + ((ch ^ (r32 & (DVB * 4 - 1))) * 16) + 8 * hi) = w; }
            constexpr int CPR = DVB * 4, RPP = 64 / CPR;
#pragma unroll
            for (int p = 0; p < 32 / RPP; ++p) { const int row = p * RPP + lane / CPR, ch = lane % CPR;
                const v4u y = *(const LAS v4u*)(stg + row * (DVB * 64) + ((ch ^ (row & (CPR - 1))) * 16));
                const size_t go = (size_t)ATT_QROW(row) * 1024 + vcol + ch * 8;
                const v4u z = *(const v4u*)(SZ + go);
                v4u w; w.x = cvtpk(bflo(y.x) * bflo(z.x), bfhi(y.x) * bfhi(z.x)); w.y = cvtpk(bflo(y.y) * bflo(z.y), bfhi(y.y) * bfhi(z.y));
                w.z = cvtpk(bflo(y.z) * bflo(z.z), bfhi(y.z) * bfhi(z.z)); w.w = cvtpk(bflo(y.w) * bflo(z.w), bfhi(y.w) * bfhi(z.w));
                *(v4u*)(YZ + go) = w; }
        }
        __syncthreads();
    }
}

#define XB_TMO      128
#define XB_XCNT(j)  (256  + 64 * (j))
#define XB_XSUB(j)  (1280 + 64 * (j))
#define XB_XGEN(j)  (2304 + 64 * (j))
#define XB_TOP      3328
#define XB_TOPGEN   3392
#define XCD_BAR_WORDS 3456
#define XB_SPIN_CAP (1u << 18)

__device__ __forceinline__ unsigned xb_ld(unsigned* p)              { return __hip_atomic_load(p, __ATOMIC_RELAXED, __HIP_MEMORY_SCOPE_AGENT); }
__device__ __forceinline__ unsigned xb_add(unsigned* p, unsigned v) { return __hip_atomic_fetch_add(p, v, __ATOMIC_RELAXED, __HIP_MEMORY_SCOPE_AGENT); }
__device__ __forceinline__ unsigned xb_xcc_id() { return (unsigned)__builtin_amdgcn_s_getreg((3 << 11) | 20) & 0xFu; }
#define XB_SPIN(cond, bar) do { unsigned _sp = 0; while (cond) { __builtin_amdgcn_s_sleep(1); \
    if ((++_sp & 255u) == 0u) { if (xb_ld(&(bar)[XB_TMO])) break; if (_sp > XB_SPIN_CAP) { atomicAdd(&(bar)[XB_TMO], 1u); break; } } } } while (0)

struct XcdBarrier {
    unsigned* bar; unsigned x;
    volatile LAS unsigned* st;
};

__device__ __forceinline__ XcdBarrier xcd_barrier_post(unsigned* bar, volatile LAS unsigned* st) {
    XcdBarrier b; b.bar = bar; b.x = xb_xcc_id(); b.st = st;
    if (threadIdx.x == 0) (void)xb_add(&bar[XB_XCNT(b.x)], 1u);
    return b;
}
__device__ __forceinline__ void xcd_barrier_complete(unsigned* bar, unsigned x, unsigned& nloc, unsigned& nx) {
    const unsigned G = gridDim.x * gridDim.y * gridDim.z;
    unsigned sum, cnt, mine, sp = 0u;
    for (;;) {
        sum = 0u; cnt = 0u; mine = 0u;
#pragma unroll
        for (unsigned j = 0; j < 16; ++j) { const unsigned c = xb_ld(&bar[XB_XCNT(j)]); sum += c; cnt += (c > 0u) ? 1u : 0u; mine = (j == x) ? c : mine; }
        if (sum == G) break;
        __builtin_amdgcn_s_sleep(1);
        if ((++sp & 255u) == 0u) { if (xb_ld(&bar[XB_TMO])) break; if (sp > XB_SPIN_CAP) { atomicAdd(&bar[XB_TMO], 1u); break; } }
    }
    nloc = mine > 0u ? mine : 1u; nx = cnt > 0u ? cnt : 1u;
}

__device__ __forceinline__ void xcd_barrier(const XcdBarrier& b) {
    asm volatile("s_waitcnt vmcnt(0)" ::: "memory");
    __syncthreads();
    if (threadIdx.x == 0) {
        unsigned* bar = b.bar;
        __builtin_amdgcn_s_waitcnt(0);
        unsigned nloc = b.st[0], nx = b.st[1];
        if (nloc == 0u) { xcd_barrier_complete(bar, b.x, nloc, nx); b.st[0] = nloc; b.st[1] = nx; }
        const unsigned old = xb_add(&bar[XB_XSUB(b.x)], 1u);
        const unsigned gen = old / nloc;
        if (old + 1u == (gen + 1u) * nloc) {
            __builtin_amdgcn_fence(__ATOMIC_RELEASE, "agent");
            asm volatile("s_waitcnt vmcnt(0)" ::: "memory");
            const unsigned og = xb_add(&bar[XB_TOP], 1u);
            const unsigned tg = og / nx;
            if (og + 1u == (tg + 1u) * nx) xb_add(&bar[XB_TOPGEN], 1u);
            else XB_SPIN(xb_ld(&bar[XB_TOPGEN]) == tg, bar);
            __builtin_amdgcn_fence(__ATOMIC_ACQUIRE, "agent");
            xb_add(&bar[XB_XGEN(b.x)], 1u);
            asm volatile("s_waitcnt vmcnt(0)" ::: "memory");
        } else {
            XB_SPIN(xb_ld(&bar[XB_XGEN(b.x)]) == gen, bar);
            __builtin_amdgcn_fence(__ATOMIC_ACQUIRE, "agent");
            asm volatile("s_waitcnt vmcnt(0)" ::: "memory");
        }
    }
    __syncthreads();
}
__device__ __forceinline__ void p0_transpose_item(const float* W, int K, int N, bf16* WT, int row_off, LAS float* scr, int item, int lane) {
    const int nblk = N / 32, kb = item / nblk, nb = item % nblk, k0 = 64 * kb, n0 = 32 * nb;
    float wv[32];
#pragma unroll
    for (int i = 0; i < 32; ++i) { const int kk = 2 * i + (lane >> 5); wv[i] = W[(size_t)(k0 + kk) * N + n0 + (lane & 31)]; }
#pragma unroll
    for (int i = 0; i < 32; ++i) { const int kk = 2 * i + (lane >> 5); scr[kk * 33 + (lane & 31)] = wv[i]; }
    LDS_WAIT(); asm volatile("" ::: "memory");
    const int c = lane & 7;
#pragma unroll
    for (int j = 0; j < 4; ++j) { const int n = (lane >> 3) + 8 * j; const LAS float* s = scr + (8 * c) * 33 + n;
        v4u o; o.x = pk2(s[0 * 33], s[1 * 33]); o.y = pk2(s[2 * 33], s[3 * 33]); o.z = pk2(s[4 * 33], s[5 * 33]); o.w = pk2(s[6 * 33], s[7 * 33]);
        *(GAS v4u*)(WT + (size_t)(row_off + n0 + n) * K + k0 + 8 * c) = o; }
    LDS_WAIT(); asm volatile("" ::: "memory");
}

__device__ __forceinline__ void sincos_d(double x, double& s, double& c) {
    const double n = __builtin_rint(x * 0.63661977236758134308);
    const double r = (x - n * 1.57079632679489655800) - n * 6.12323399573676603587e-17;
    const double r2 = r * r;
    double sp = -7.6471637318198164759e-13; sp = sp * r2 + 1.6059043836821614599e-10; sp = sp * r2 - 2.5052108385441718775e-08; sp = sp * r2 + 2.7557319223985890653e-06;
    sp = sp * r2 - 1.9841269841269841270e-04; sp = sp * r2 + 8.3333333333333333333e-03; sp = sp * r2 - 1.6666666666666666667e-01; sp = r + r * r2 * sp;
    double cp = 4.7794773323873852974e-14; cp = cp * r2 - 1.1470745597729724714e-11; cp = cp * r2 + 2.0876756987868098979e-09; cp = cp * r2 - 2.7557319223985890653e-07;
    cp = cp * r2 + 2.4801587301587301587e-05; cp = cp * r2 - 1.3888888888888888889e-03; cp = cp * r2 + 4.1666666666666666667e-02; cp = cp * r2 - 0.5; cp = 1.0 + r2 * cp;
    const int q = ((int)n) & 3;
    s = (q == 0) ? sp : (q == 1) ? cp : (q == 2) ? -sp : -cp;
    c = (q == 0) ? cp : (q == 1) ? -sp : (q == 2) ? -cp : sp;
}

struct OneUnit { int pm, pn;
    __device__ __forceinline__ bool next(int i, pg8::Unit& u) const { if (i) return false; u.pm = pm; u.pn = pn; return true; }
    __device__ __forceinline__ void a_ready(const pg8::Unit&) const {}
    __device__ __forceinline__ void done(const pg8::Unit&) const {} };
__device__ __forceinline__ void sub_barrier(unsigned* ctr, unsigned target, int tid) {
    asm volatile("s_waitcnt vmcnt(0)" ::: "memory"); __syncthreads();
    if (tid == 0) {
        __builtin_amdgcn_fence(__ATOMIC_RELEASE, "agent"); asm volatile("s_waitcnt vmcnt(0)" ::: "memory");
        __hip_atomic_fetch_add(ctr, 1u, __ATOMIC_RELAXED, __HIP_MEMORY_SCOPE_AGENT);
        unsigned sp = 0;
        while (__hip_atomic_load(ctr, __ATOMIC_RELAXED, __HIP_MEMORY_SCOPE_AGENT) < target) { __builtin_amdgcn_s_sleep(2); if (++sp > (1u << 22)) break; }
        __builtin_amdgcn_fence(__ATOMIC_ACQUIRE, "agent"); asm volatile("s_waitcnt vmcnt(0)" ::: "memory");
    }
    __syncthreads();
}
constexpr int NCW = 32;
struct Args { const float* in[13]; float* out; unsigned char* ws; int ph_lo, ph_hi; };

__global__ void __launch_bounds__(NWAVES * 64, 2) fwd_kernel(Args args) {
    extern __shared__ __attribute__((aligned(16))) unsigned char lds_raw[];
    LAS unsigned char* lds = (LAS unsigned char*)lds_raw;
    cg::grid_group grid = cg::this_grid();
    const int tid0 = threadIdx.x, wave = __builtin_amdgcn_readfirstlane(tid0 >> 6);
#define OPAQUE_TID() int tid = wave * 64 + lane_id_v(); asm volatile("" : "+v"(tid)); const int lane = tid & 63
    const int G = gridDim.x, bx = blockIdx.x;
    const int vcu = (G % 8 == 0) ? (bx % 8) * (G / 8) + bx / 8 : bx;
    const int gw = vcu * NWAVES + wave, NGW = G * NWAVES;
    unsigned char* ws = args.ws;
    const float* x_in = args.in[0]; const float* c_in = args.in[1]; const float* ctx_in = args.in[2]; const float* cctx_in = args.in[3];
    const float* w_mod = args.in[4]; const float* b_mod = args.in[5]; const float* w_in = args.in[6]; const float* w_out = args.in[7];
    const float* ln_g = args.in[8]; const float* ln_b = args.in[9]; const float* na_rpb = args.in[10]; const float* diff_lambda = args.in[11]; const float* diff_subln = args.in[12];
    float* statsB = (float*)(ws + WS_STATS); float* modT = (float*)(ws + WS_MOD); float* cosT = (float*)(ws + WS_COS); float* sinT = (float*)(ws + WS_SIN);
    bf16* Win_t = (bf16*)(ws + WS_WIN); bf16* Wout_t = (bf16*)(ws + WS_WOUT);
    float* XRx = args.out; float* XRc = (float*)(ws + WS_XRC);
    bf16* XN = (bf16*)(ws + WS_XN); bf16* Qb = (bf16*)(ws + WS_Q); bf16* Kb = (bf16*)(ws + WS_K); bf16* Vb = (bf16*)(ws + WS_V); bf16* Zb = (bf16*)(ws + WS_Z); bf16* YZ = (bf16*)(ws + WS_YZ);
    const int lo = args.ph_lo, hi_ph = args.ph_hi;
    volatile LAS unsigned* MISC = (volatile LAS unsigned*)(lds + LDS_BYTES - 256);
    if (tid0 < 64) MISC[tid0] = 0u;
    __syncthreads();
    XcdBarrier bar = xcd_barrier_post((unsigned*)(args.ws + WS_CTL) + CW_BAR, MISC + 8);
#define IN_PH(k) (lo <= (k) && (k) < hi_ph)
#define SEAM(k) do { if (lo <= (k) && (k) + 1 < hi_ph) xcd_barrier(bar); } while (0)
    if (lo < 0) grid.sync();

    if (IN_PH(0)) for (int rep0_ = 0; rep0_ < REP_P0; ++rep0_) {
        OPAQUE_TID();
        if (rep0_) __syncthreads();
        LAS float* scr = (LAS float*)(lds + wave * 16384);
        constexpr int PER_L = 2048 + 512, NIT = DEPTH * PER_L;
        for (int it = gw; it < NIT; it += NGW) {
            const int l = it / PER_L, r = it % PER_L;
            if (r < 2048) p0_transpose_item(w_in + (size_t)l * 1024 * 4096, 1024, 4096, Win_t + (size_t)l * 4096 * 1024, 0, scr, r, lane);
            else p0_transpose_item(w_out + (size_t)l * 1024 * 1024, 1024, 1024, Wout_t + (size_t)l * 1024 * 1024, 0, scr, r - 2048, lane);
        }
        { const int gt = bx * (NWAVES * 64) + tid;
          if (gt < 1024) { const float invf[16] = {1.0f, 0.5623413324356079f, 0.3162277638912201f, 0.17782793939113617f, 0.10000000149011612f, 0.05623413249850273f, 0.03162277489900589f, 0.017782794311642647f,
                                                   0.009999999776482582f, 0.005623413249850273f, 0.003162277629598975f, 0.0017782794311642647f, 0.0010000000474974513f, 0.000562341301701963f, 0.0003162277571391314f, 0.00017782794020604342f};
              const int pos = gt >> 4, f = gt & 15; float fv = invf[0];
#pragma unroll
              for (int q = 1; q < 16; ++q) fv = (f == q) ? invf[q] : fv;
              const float ang = (float)pos * fv; double s, c; sincos_d((double)ang, s, c); cosT[gt] = (float)c; sinT[gt] = (float)s; } }
        __syncthreads();
        LAS float* sil = (LAS float*)lds;
        LAS float* red = sil + 9 * 1024;
        for (int i = tid; i < 9 * 1024; i += NWAVES * 64) { const int j = i >> 10, k = i & 1023; const float cv = j < 8 ? c_in[j * 1024 + k] : cctx_in[k]; sil[i] = cv / (1.f + expf(-cv)); }
        __syncthreads();
        for (int item = bx; item < DEPTH * 48; item += G) {
            const int l = item / 48, cb = item % 48;
            const float* W = w_mod + (size_t)l * 1024 * 3072 + cb * 64 + lane;
            float a0 = 0.f, a1 = 0.f, a2 = 0.f, a3 = 0.f, a4 = 0.f, a5 = 0.f, a6 = 0.f, a7 = 0.f, a8 = 0.f;
#pragma unroll 32
            for (int kk = 0; kk < 128; ++kk) { const int k = wave * 128 + kk; const float wv = W[(size_t)k * 3072];
                a0 += sil[k] * wv; a1 += sil[1024 + k] * wv; a2 += sil[2048 + k] * wv; a3 += sil[3072 + k] * wv; a4 += sil[4096 + k] * wv;
                a5 += sil[5120 + k] * wv; a6 += sil[6144 + k] * wv; a7 += sil[7168 + k] * wv; a8 += sil[8192 + k] * wv; }
            LAS float* rw = red + wave * 9 * 64 + lane;
            rw[0] = a0; rw[64] = a1; rw[128] = a2; rw[192] = a3; rw[256] = a4; rw[320] = a5; rw[384] = a6; rw[448] = a7; rw[512] = a8;
            __syncthreads();
            for (int i = tid; i < 9 * 64; i += NWAVES * 64) { const int j = i >> 6, cc = i & 63; float s = b_mod[l * 3072 + cb * 64 + cc];
#pragma unroll
                for (int w = 0; w < 8; ++w) s += red[(w * 9 + j) * 64 + cc];
                modT[(size_t)(l * 9 + j) * 3072 + cb * 64 + cc] = s; }
            __syncthreads();
        }
    }
    SEAM(0);

    for (int l = 0; l < DEPTH; ++l) {
        const bool need_ctx = l < DEPTH - 1;
        if (IN_PH(1 + 4 * l)) for (int repa_ = 0; repa_ < REP_A; ++repa_) {
            OPAQUE_TID(); const float* modl = modT + (size_t)l * 9 * 3072;
            const bool side = (l > 0) && (G > 2 * NCW);
            int row_lo = gw, row_hi = MT, row_st = NGW;
            if (side) {
                if (bx < NCW) {
                    const int lp = l - 1; const float* modp = modT + (size_t)lp * 9 * 3072;
                    pg8::Gemm g{YZ, Wout_t + (size_t)lp * 1024 * 1024, MT, 1024, 1024}; OneUnit S{MX / 256 + (bx >> 2), bx & 3};
                    pg8::EpiOut E{lp == 0 ? x_in : XRx, lp == 0 ? ctx_in : XRc, XRx, XRc, modp, lp == 0 ? nullptr : statsB, ln_g + (lp - 1) * 1024, ln_b + (lp - 1) * 1024};
                    pg8::gemm_phase<pg8::EpiOut, OneUnit, true, true>(lds, g, S, E, wave);
                    sub_barrier((unsigned*)(ws + WS_CTL) + CW_SUB, (unsigned)(NCW * l), tid);
                    row_lo = MX + bx * NWAVES + wave; row_hi = MT; row_st = NCW * NWAVES;
                } else { row_lo = (bx - NCW) * NWAVES + wave; row_hi = MX; row_st = (G - NCW) * NWAVES; }
            }
            constexpr int RB = 4;
            for (int row0 = row_lo; row0 < row_hi; row0 += RB * row_st) {
                f32x4 v[RB][4];
#pragma unroll
                for (int u = 0; u < RB; ++u) { const int row = row0 + u * row_st; const int rowc = row < row_hi ? row : row0;
                    const bool isc = rowc >= MX; const int rr = isc ? rowc - MX : rowc;
                    const float* src = (l == 0) ? (isc ? ctx_in : x_in) : (isc ? XRc : XRx);
                    const GAS f32x4* xr = (const GAS f32x4*)(src + (size_t)rr * 1024) + lane;
#pragma unroll
                    for (int j = 0; j < 4; ++j) v[u][j] = xr[64 * j]; }
#pragma unroll
                for (int u = 0; u < RB; ++u) { const int row = row0 + u * row_st; if (row >= row_hi) break;
                    const bool isc = row >= MX;
                    if (l > 0) {
                        float s = 0.f;
#pragma unroll
                        for (int j = 0; j < 4; ++j) s += (v[u][j].x + v[u][j].y) + (v[u][j].z + v[u][j].w);
                        const float mean = wave_sum(s) * (1.f / 1024.f); float s2 = 0.f;
#pragma unroll
                        for (int j = 0; j < 4; ++j) { v[u][j] = v[u][j] - mean; s2 += (v[u][j].x * v[u][j].x + v[u][j].y * v[u][j].y) + (v[u][j].z * v[u][j].z + v[u][j].w * v[u][j].w); }
                        const float rstd = 1.f / sqrtf(wave_sum(s2) * (1.f / 1024.f) + LN_EPS);
                        if (lane == 0) { float* sp = statsB + 2 * (size_t)row; sp[0] = mean; sp[1] = rstd; }
#pragma unroll
                        for (int j = 0; j < 4; ++j) { const f32x4 g4 = *((const f32x4*)(ln_g + (l - 1) * 1024) + lane + 64 * j), b4 = *((const f32x4*)(ln_b + (l - 1) * 1024) + lane + 64 * j);
                            v[u][j] = v[u][j] * rstd * g4 + b4; }
                    }
                    const float* mrow = modl + (isc ? 8 : (row >> 12)) * 3072;
                    GAS v2u* o8 = (GAS v2u*)(XN + (size_t)row * 1024) + lane;
#pragma unroll
                    for (int j = 0; j < 4; ++j) { const f32x4 sh = *((const f32x4*)mrow + lane + 64 * j), sc = *((const f32x4*)(mrow + 1024) + lane + 64 * j);
                        const f32x4 h = v[u][j] * (sc + 1.f) + sh; v2u w; w.x = cvtpk(h.x, h.y); w.y = cvtpk(h.z, h.w); o8[64 * j] = w; }
                }
            }
        }
        SEAM(1 + 4 * l);
        if (IN_PH(2 + 4 * l)) for (int rep_ = 0; rep_ < REP_B; ++rep_) {
            pg8::Gemm g{XN, Win_t + (size_t)l * 4096 * 1024, MT, 4096, 1024}; pg8::StaticOrder S; S.init(MT, 4096, G, bx);
            pg8::EpiIn E{Qb, ACT / 2, l & 1, cosT, sinT};
            pg8::gemm_phase<pg8::EpiIn, pg8::StaticOrder, true, true>(lds, g, S, E, wave);
        }
        SEAM(2 + 4 * l);
        if (IN_PH(3 + 4 * l)) {
            OPAQUE_TID();
#ifndef NO_NA
            if ((l & 1) == 0) for (int rep_ = 0; rep_ < REP_NA; ++rep_) {
                LAS float* rpbL = (LAS float*)(lds + NAB_RPB);
                const float* rpb = na_rpb + (size_t)(l >> 1) * 16 * 15 * 31;
                constexpr int NXU = NB * 16 * 16; const int per = (NXU + G - 1) / G;
                int hl = -1;
                for (int i = 0; i < per; ++i) { const int u = vcu * per + i; if (u >= NXU) break;
                    const int bh = u >> 4, rq = u & 15, b = bh >> 4, h = bh & 15, rlo = 4 * rq;
                    const int kr0 = clampi(rlo - 4, 0, 56), n1 = clampi(rlo - 1, 0, 56) + 8 - kr0;
                    if (h != hl) {
                        for (int q = tid; q < 15 * 31; q += NWAVES * 64) rpbL[q] = rpb[h * 465 + q] * LOG2E;
                        __syncthreads();
                        LAS float* tint = (LAS float*)(lds + NAB_TINT); LAS float* tb = (LAS float*)(lds + NAB_TB);
                        for (int q = tid; q < 16 * 128; q += NWAVES * 64) { const int tr = q >> 7, dc = (q & 127) - 48; tint[q] = (tr >= 1 && dc >= 7 && dc <= 22) ? rpbL[(tr - 1) * 31 + dc] : -1e30f; }
                        for (int q = tid; q < 15 * 16 * 64; q += NWAVES * 64) { const int v = q >> 10, rem = q & 1023, tr = rem >> 6, kc = rem & 63, w = v < 8 ? v : v + 49;
                            const int c0 = clampi(w - 8, 0, 48), dc = kc - w + 15; tb[q] = (tr >= 1 && kc >= c0 && kc <= c0 + 15) ? rpbL[(tr - 1) * 31 + dc] : -1e30f; }
                        hl = h; }
                    attn_unit<2, true, false>((PROBE_NA && rep_ == 0) ? PROBE_NA : 0, wave, lds, Qb, Kb, Vb, Zb, (PROBE_NA && rep_ == 0) ? XN : YZ, b * SEQ + rlo * 64, h * 64, h * 64, b * SEQ + kr0 * 64, n1, MX + b * CTXL, 4, kr0, true, rlo, rpbL, 0.f, 0.f, nullptr);
                }
                if (need_ctx) for (int u = vcu; u < NB * 16; u += G) { const int b = u >> 4, h = u & 15;
                    attn_unit<2, true, false>(0, wave, lds, Qb, Kb, Vb, Zb, YZ, MX + b * CTXL, h * 64, h * 64, 0, 0, MX + b * CTXL, 4, 0, false, 0, rpbL, 0.f, 0.f, nullptr); }
            }
#endif
#ifndef NO_DIFF
            if ((l & 1) == 1) for (int rep_ = 0; rep_ < REP_DIFF; ++rep_) {
                const float li = (l == 1) ? 0.35550906759096934f : 0.5560582041556406f;
                const float* lp = diff_lambda + (size_t)(l >> 1) * 256;
                const float sa = wave_sum(lp[lane] * lp[64 + lane]), sb = wave_sum(lp[128 + lane] * lp[192 + lane]);
                const float lam = expf(sa) - expf(sb) + li;
                const float* subg = diff_subln + (size_t)(l >> 1) * 128;
                constexpr int NXU = NB * 8 * 32; const int per = (NXU + G - 1) / G;
                for (int i = 0; i < per; ++i) { const int u = vcu * per + i; if (u >= NXU) break;
                    const int bh = u >> 5, qb = u & 31, b = bh >> 3, h = bh & 7;
                    attn_unit<4, false, true>((PROBE_DIFF && rep_ == 0) ? PROBE_DIFF : 0, wave, lds, Qb, Kb, Vb, Zb, (PROBE_DIFF && rep_ == 0) ? XN : YZ, b * SEQ + qb * 128, h * 128, h * 128, b * SEQ, 64, MX + b * CTXL, 4, 0, true, 0, nullptr, lam, 1.f - li, subg);
                }
                if (need_ctx) for (int u = vcu; u < NB * 8 * 2; u += G) { const int b = u >> 4, h = (u >> 1) & 7, qh = u & 1;
                    attn_unit<4, false, true>(0, wave, lds, Qb, Kb, Vb, Zb, YZ, MX + b * CTXL + qh * 128, h * 128, h * 128, 0, 0, MX + b * CTXL, 4, 0, false, 0, nullptr, lam, 1.f - li, subg); }
            }
#endif
        }
        SEAM(3 + 4 * l);
        if (IN_PH(4 + 4 * l)) {
            const float* modl = modT + (size_t)l * 9 * 3072;
            const int Mo = (need_ctx && !(G > 2 * NCW)) ? MT : MX;
            pg8::Gemm g{YZ, Wout_t + (size_t)l * 1024 * 1024, Mo, 1024, 1024}; pg8::StaticOrder S; S.init(Mo, 1024, G, bx);
            for (int repd_ = 0; repd_ < REP_D; ++repd_) {
            pg8::EpiOut E{l == 0 ? x_in : XRx, l == 0 ? ctx_in : XRc, (repd_ + 1 < REP_D) ? (float*)Qb : XRx, XRc, modl, l == 0 ? nullptr : statsB, ln_g + (l - 1) * 1024, ln_b + (l - 1) * 1024};
            pg8::gemm_phase<pg8::EpiOut, pg8::StaticOrder, true, true>(lds, g, S, E, wave);
            }
        }
        SEAM(4 + 4 * l);
    }
    if (IN_PH(NPH - 1)) {
        OPAQUE_TID();
        constexpr int RB = 4;
        for (int row0 = gw; row0 < MX; row0 += RB * NGW) {
            f32x4 v[RB][4];
#pragma unroll
            for (int u = 0; u < RB; ++u) { const int row = row0 + u * NGW; const int rowc = row < MX ? row : row0;
                const GAS f32x4* xr = (const GAS f32x4*)(XRx + (size_t)rowc * 1024) + lane;
#pragma unroll
                for (int j = 0; j < 4; ++j) v[u][j] = xr[64 * j]; }
#pragma unroll
            for (int u = 0; u < RB; ++u) { const int row = row0 + u * NGW; if (row >= MX) break;
                GAS f32x4* xo = (GAS f32x4*)(XRx + (size_t)row * 1024) + lane;
                float s = 0.f;
#pragma unroll
                for (int j = 0; j < 4; ++j) s += (v[u][j].x + v[u][j].y) + (v[u][j].z + v[u][j].w);
                const float mean = wave_sum(s) * (1.f / 1024.f); float s2 = 0.f;
#pragma unroll
                for (int j = 0; j < 4; ++j) { v[u][j] = v[u][j] - mean; s2 += (v[u][j].x * v[u][j].x + v[u][j].y * v[u][j].y) + (v[u][j].z * v[u][j].z + v[u][j].w * v[u][j].w); }
                const float rstd = 1.f / sqrtf(wave_sum(s2) * (1.f / 1024.f) + LN_EPS);
#pragma unroll
                for (int j = 0; j < 4; ++j) { const f32x4 g4 = *((const f32x4*)(ln_g + 3 * 1024) + lane + 64 * j), b4 = *((const f32x4*)(ln_b + 3 * 1024) + lane + 64 * j);
                    xo[64 * j] = v[u][j] * rstd * g4 + b4; }
            }
        }
    }
#undef IN_PH
#undef SEAM
}

#ifndef N_LAUNCH_MODE_GUARD_DUMMY
#endif
#ifndef N_LAUNCH_MODE
#define N_LAUNCH_MODE 1
#endif
extern "C" void kernel_launch(void* const* d_in, const int* in_sizes, int n_in, void* d_out, int out_size, void* d_ws, size_t ws_size, hipStream_t stream) {
    static int grid = 0;
    if (grid == 0) {
        if (n_in != 13 || out_size != MX * DM || ws_size < WS_END) { fprintf(stderr, "kernel_launch: unexpected shapes (n_in %d out %d ws %zu)\n", n_in, out_size, ws_size); grid = -1; return; }
        int dev = 0, cus = 0, per_cu = 0;
        hipGetDevice(&dev); hipDeviceGetAttribute(&cus, hipDeviceAttributeMultiprocessorCount, dev);
        if (hipFuncSetAttribute((const void*)fwd_kernel, hipFuncAttributeMaxDynamicSharedMemorySize, LDS_BYTES) != hipSuccess) { fprintf(stderr, "kernel_launch: hipFuncSetAttribute failed\n"); grid = -1; return; }
        if (hipOccupancyMaxActiveBlocksPerMultiprocessor(&per_cu, (const void*)fwd_kernel, NWAVES * 64, LDS_BYTES) != hipSuccess || per_cu < 1) { fprintf(stderr, "kernel_launch: occupancy query gave %d\n", per_cu); per_cu = 1; }
        (void)hipGetLastError();
        grid = cus * 1;
        if (grid <= 0) grid = 256;
    }
    if (grid < 0) return;
    if (hipMemsetAsync((char*)d_ws + WS_CTL, 0, CTL_ZERO_BYTES, stream) != hipSuccess) { fprintf(stderr, "kernel_launch: hipMemsetAsync failed\n"); return; }
    Args a{};
    for (int i = 0; i < 13; ++i) a.in[i] = (const float*)d_in[i];
    a.out = (float*)d_out; a.ws = (unsigned char*)d_ws;
#if N_LAUNCH_MODE == 1
    a.ph_lo = 0; a.ph_hi = NPH;
    void* kargs[] = {&a};
    hipError_t e = hipLaunchCooperativeKernel((const void*)fwd_kernel, dim3(grid), dim3(NWAVES * 64), kargs, LDS_BYTES, stream);
    if (e != hipSuccess) fprintf(stderr, "cooperative launch failed: %s (grid %d)\n", hipGetErrorString(e), grid);
#else
    for (int p = 0; p < NPH; ++p) { a.ph_lo = p; a.ph_hi = p + 1; hipLaunchKernelGGL(fwd_kernel, dim3(grid), dim3(NWAVES * 64), LDS_BYTES, stream, a); }
#endif
}
```

```cpp
#include <hip/hip_runtime.h>
#include <hip/hip_cooperative_groups.h>
#include <cstdio>
#include <cstdint>
namespace cg = cooperative_groups;
#ifndef REP_P0
#define REP_P0 1
#endif
#ifndef REP_A
#define REP_A 1
#endif
#ifndef REP_D
#define REP_D 1
#endif
#ifndef REP_B
#define REP_B 1
#endif
#ifndef REP_NA
#define REP_NA 1
#endif
#ifndef REP_DIFF
#define REP_DIFF 1
#endif
#ifndef PROBE_NA
#define PROBE_NA 0
#endif
#ifndef PROBE_DIFF
#define PROBE_DIFF 0
#endif
__device__ __forceinline__ int lane_id_v() { int l; asm volatile("v_mbcnt_lo_u32_b32 %0, -1, 0\n\tv_mbcnt_hi_u32_b32 %0, -1, %0" : "=v"(l)); return l; }
#define N_LAUNCH_MODE 1
namespace pg8 {
#define PG8_LAS __attribute__((address_space(3)))
typedef unsigned short bf16_t;
typedef short bf16x8 __attribute__((ext_vector_type(8)));
typedef float f32x4 __attribute__((ext_vector_type(4)));
typedef unsigned u32x4 __attribute__((ext_vector_type(4)));
constexpr int BM = 256, BK = 64, HALF = 128, HTB = HALF * BK * 2  , STAGE_BYTES = 8 * HTB, NXCD = 8, WGM = 8;

__host__ __device__ __forceinline__ int lds_byte(int r, int c) { const int st = (r >> 4) * 2 + (c >> 5), rr = r & 15, cc = c & 31, ob = rr * 64 + cc * 2; return st * 1024 + (ob ^ (((ob >> 9) & 1) << 5)); }
__host__ __device__ __forceinline__ void stage_rc(int b, int& R, int& C) { const int st = b / 1024, sb = b % 1024, swz = sb ^ (((sb >> 9) & 1) << 5); R = (st >> 1) * 16 + swz / 64; C = (st & 1) * 32 + (swz % 64) / 2; }
__host__ __device__ __forceinline__ int perm32(int rho) { const int n = rho >> 4, i = rho & 15; return 8 * (i >> 2) + 4 * n + (i & 3); }

struct Unit { int pm, pn; };
struct Gemm { const bf16_t* A; const bf16_t* Bt; int M, N, K; };

struct StaticOrder {
    int nM, nN, nwg, G, c;
    __host__ __device__ void init(int M, int N, int G_, int c_) { nM = M / BM; nN = N / BM; nwg = nM * nN; G = G_; c = c_; }
    __host__ __device__ bool next(int i, Unit& u) const {
        const long L = (long)i * G + c; if (L >= nwg) return false;
        int wgid = (int)L; { const int q = nwg / NXCD, r = nwg % NXCD, xcd = wgid % NXCD, off = wgid / NXCD; wgid = (xcd < r ? xcd * (q + 1) : r * (q + 1) + (xcd - r) * q) + off; }
        const int nig = WGM * nN, gid = wgid / nig, fm = gid * WGM, gsz = (nM - fm) < WGM ? (nM - fm) : WGM;
        u.pm = fm + ((wgid % nig) % gsz); u.pn = (wgid % nig) / gsz; return true;
    }
    __device__ __forceinline__ void a_ready(const Unit&) const {}
    __device__ __forceinline__ void done(const Unit&) const {}
};
__device__ __forceinline__ unsigned cvt_pk_bf16(float lo, float hi) { unsigned r; asm volatile("v_cvt_pk_bf16_f32 %0, %1, %2" : "=v"(r) : "v"(lo), "v"(hi)); return r; }
template <class Epi, class Sched, bool ALIGN_EPI = false, bool SP2 = false>
__device__ __forceinline__ void gemm_phase(PG8_LAS unsigned char* lds, const Gemm g, const Sched& S, const Epi& E, const int wid_in) {
    int tid_o = wid_in * 64 + lane_id_v(); asm volatile("" : "+v"(tid_o));
    const int tid = tid_o, wid = __builtin_amdgcn_readfirstlane(tid >> 6), lane = tid & 63, wr = wid >> 2, wc = wid & 3, fr = lane & 15, fq = lane >> 4;
    const int K = g.K, nt = K / BK;
    unsigned voffA[2], voffB[2];
#pragma unroll
    for (int i = 0; i < 2; ++i) { int R, C; stage_rc(tid * 16 + i * 8192, R, C); const int Rb = Epi::PERM ? ((R & ~31) + perm32(R & 31)) : R;
        voffA[i] = (unsigned)(R * K + C) * 2u; voffB[i] = (unsigned)(Rb * K + C) * 2u; }
    const size_t kstep = (size_t)(BK * 2);
    const size_t hstep = (size_t)HALF * K * 2;
    const size_t tstep = 2 * hstep;
    const unsigned ldsw = (unsigned)wid * 1024u;
    const int aoff = lds_byte(wr * 64 + fr, fq * 8), boff = lds_byte(wc * 32 + fr, fq * 8);
#define PG8_SA(b, h) (((b) * 2 + (h)) * HTB)
#define PG8_SB(b, h) ((4 + (b) * 2 + (h)) * HTB)
#define PG8_STAGE(bufoff, gbase, voff) do { _Pragma("unroll") for (int _i = 0; _i < 2; ++_i) \
        __builtin_amdgcn_global_load_lds((const unsigned*)((const char*)(gbase) + (voff)[_i]), (PG8_LAS unsigned*)(lds + (bufoff) + ldsw + _i * 8192), 16, 0, 0); } while (0)
#define PG8_LDA(dst, b, h) do { _Pragma("unroll") for (int m = 0; m < 4; ++m) _Pragma("unroll") for (int k = 0; k < 2; ++k) dst[m][k] = *(const PG8_LAS bf16x8*)(lds + PG8_SA(b, h) + aoff + m * 2048 + k * 1024); } while (0)
#define PG8_LDB(dst, b, h) do { _Pragma("unroll") for (int n = 0; n < 2; ++n) _Pragma("unroll") for (int k = 0; k < 2; ++k) dst[n][k] = *(const PG8_LAS bf16x8*)(lds + PG8_SB(b, h) + boff + n * 2048 + k * 1024); } while (0)
#define PG8_MMA(ai, bj, At, Bt) do { __builtin_amdgcn_s_setprio(1); _Pragma("unroll") for (int m = 0; m < 4; ++m) _Pragma("unroll") for (int n = 0; n < 2; ++n) _Pragma("unroll") for (int k = 0; k < 2; ++k) \
        acc[ai][bj][m][n] = __builtin_amdgcn_mfma_f32_16x16x32_bf16(Bt[n][k], At[m][k], acc[ai][bj][m][n], 0, 0, 0); __builtin_amdgcn_s_setprio(0); } while (0)
#define PG8_WAIT_V(n) asm volatile("s_waitcnt vmcnt(" #n ")" ::: "memory")
#define PG8_WAIT_L(n) asm volatile("s_waitcnt lgkmcnt(" #n ")" ::: "memory")
#define PG8_BAR __builtin_amdgcn_s_barrier()
#define PG8_SCHED __builtin_amdgcn_sched_barrier(0)
    Unit cur, nxt; int ui = 0;
    if (!S.next(0, cur)) return;
    f32x4 acc[2][2][4][2];
#pragma unroll
    for (int a = 0; a < 2; ++a)
#pragma unroll
        for (int b = 0; b < 2; ++b)
#pragma unroll
            for (int m = 0; m < 4; ++m)
#pragma unroll
                for (int n = 0; n < 2; ++n) acc[a][b][m][n] = (f32x4){0.f, 0.f, 0.f, 0.f};
    bf16x8 At[4][2], B0[2][2], B1[2][2];
    const char* cA = (const char*)g.A + (size_t)cur.pm * tstep; const char* cB = (const char*)g.Bt + (size_t)cur.pn * tstep;
    S.a_ready(cur);
    if constexpr (SP2) {
        PG8_STAGE(PG8_SB(0, 0), cB, voffB); PG8_STAGE(PG8_SB(0, 1), cB + hstep, voffB); PG8_STAGE(PG8_SA(0, 0), cA, voffA); PG8_STAGE(PG8_SA(0, 1), cA + hstep, voffA);
        if (wr == 1) PG8_BAR;
        PG8_WAIT_V(2); PG8_BAR;
        PG8_STAGE(PG8_SB(1, 0), cB + kstep, voffB); PG8_STAGE(PG8_SA(1, 0), cA + kstep, voffA); PG8_STAGE(PG8_SB(1, 1), cB + hstep + kstep, voffB);
        PG8_WAIT_V(6); PG8_BAR;
    } else {
        PG8_STAGE(PG8_SB(0, 0), cB, voffB); PG8_STAGE(PG8_SA(0, 0), cA, voffA); PG8_STAGE(PG8_SB(0, 1), cB + hstep, voffB); PG8_STAGE(PG8_SA(0, 1), cA + hstep, voffA);
        if (wr == 1) PG8_BAR;
        PG8_WAIT_V(4); PG8_BAR;
        PG8_STAGE(PG8_SB(1, 0), cB + kstep, voffB); PG8_STAGE(PG8_SA(1, 0), cA + kstep, voffA); PG8_STAGE(PG8_SB(1, 1), cB + hstep + kstep, voffB);
        PG8_WAIT_V(6); PG8_BAR;
    }
    for (;;) {
        const bool has_next = S.next(ui + 1, nxt);
        const char* nA = has_next ? (const char*)g.A + (size_t)nxt.pm * tstep : cA; const char* nB = has_next ? (const char*)g.Bt + (size_t)nxt.pn * tstep : cB;
        for (int t = 0; t < nt; t += 2) {
            const bool last = (t == nt - 2);
            const char* a1 = cA + (size_t)(t + 1) * kstep;
            const char* a2 = last ? nA : cA + (size_t)(t + 2) * kstep; const char* b2 = last ? nB : cB + (size_t)(t + 2) * kstep;
            const char* a3 = a2 + kstep; const char* b3 = b2 + kstep;
            if (last && has_next) S.a_ready(nxt);
            if constexpr (SP2) {
            PG8_LDB(B0, 0, 0); PG8_LDB(B1, 0, 1); PG8_SCHED; PG8_LDA(At, 0, 0); PG8_STAGE(PG8_SA(1, 1), a1 + hstep, voffA);
            PG8_WAIT_V(8); PG8_WAIT_L(0); PG8_BAR; PG8_MMA(0, 0, At, B0); PG8_MMA(0, 1, At, B1); PG8_BAR; PG8_SCHED;
            PG8_LDA(At, 0, 1); PG8_STAGE(PG8_SB(0, 0), b2, voffB); PG8_STAGE(PG8_SB(0, 1), b2 + hstep, voffB); PG8_STAGE(PG8_SA(0, 0), a2, voffA);
            PG8_WAIT_V(8); PG8_WAIT_L(0); PG8_BAR; PG8_MMA(1, 0, At, B0); PG8_MMA(1, 1, At, B1); PG8_BAR; PG8_SCHED;
            PG8_LDB(B0, 1, 0); PG8_LDB(B1, 1, 1); PG8_SCHED; PG8_LDA(At, 1, 0); PG8_STAGE(PG8_SA(0, 1), a2 + hstep, voffA);
            PG8_WAIT_V(8); PG8_WAIT_L(0); PG8_BAR; PG8_MMA(0, 0, At, B0); PG8_MMA(0, 1, At, B1); PG8_BAR; PG8_SCHED;
            PG8_LDA(At, 1, 1); PG8_STAGE(PG8_SB(1, 0), b3, voffB); PG8_STAGE(PG8_SB(1, 1), b3 + hstep, voffB); PG8_STAGE(PG8_SA(1, 0), a3, voffA);
            PG8_WAIT_V(8); PG8_WAIT_L(0); PG8_BAR; PG8_MMA(1, 0, At, B0); PG8_MMA(1, 1, At, B1); PG8_BAR; PG8_SCHED;
            } else {
            PG8_LDB(B0, 0, 0); PG8_SCHED; PG8_LDA(At, 0, 0); PG8_STAGE(PG8_SA(1, 1), a1 + hstep, voffA);
            PG8_WAIT_L(8); PG8_BAR; PG8_WAIT_L(0); PG8_MMA(0, 0, At, B0); PG8_BAR; PG8_SCHED;
            PG8_LDB(B1, 0, 1); PG8_STAGE(PG8_SB(0, 0), b2, voffB);
            PG8_BAR; PG8_WAIT_L(0); PG8_MMA(0, 1, At, B1); PG8_BAR;
            PG8_LDA(At, 0, 1); PG8_STAGE(PG8_SA(0, 0), a2, voffA);
            PG8_BAR; PG8_WAIT_L(0); PG8_MMA(1, 0, At, B0); PG8_BAR; PG8_SCHED;
            PG8_STAGE(PG8_SB(0, 1), b2 + hstep, voffB);
            PG8_WAIT_V(6); PG8_BAR; PG8_MMA(1, 1, At, B1); PG8_BAR;
            PG8_LDB(B0, 1, 0); PG8_SCHED; PG8_LDA(At, 1, 0); PG8_STAGE(PG8_SA(0, 1), a2 + hstep, voffA);
            PG8_WAIT_L(8); PG8_BAR; PG8_WAIT_L(0); PG8_MMA(0, 0, At, B0); PG8_BAR; PG8_SCHED;
            PG8_LDB(B1, 1, 1); PG8_STAGE(PG8_SB(1, 0), b3, voffB);
            PG8_BAR; PG8_WAIT_L(0); PG8_MMA(0, 1, At, B1); PG8_BAR;
            PG8_LDA(At, 1, 1); PG8_STAGE(PG8_SA(1, 0), a3, voffA);
            PG8_BAR; PG8_WAIT_L(0); PG8_MMA(1, 0, At, B0); PG8_BAR; PG8_SCHED;
            PG8_STAGE(PG8_SB(1, 1), b3 + hstep, voffB);
            PG8_WAIT_V(6); PG8_BAR; PG8_MMA(1, 1, At, B1); PG8_BAR;
            }
        }
        if constexpr (ALIGN_EPI) { if (wr == 0) PG8_BAR; }
        if constexpr (!Epi::AFTER_DRAIN) { E(acc, cur, wr, wc, fr, fq); S.done(cur); }
        if (!has_next) break;
#pragma unroll
        for (int a = 0; a < 2; ++a)
#pragma unroll
            for (int b = 0; b < 2; ++b)
#pragma unroll
                for (int m = 0; m < 4; ++m)
#pragma unroll
                    for (int n = 0; n < 2; ++n) acc[a][b][m][n] = (f32x4){0.f, 0.f, 0.f, 0.f};
        cur = nxt; cA = nA; cB = nB; ++ui;
        if constexpr (ALIGN_EPI) { if (wr == 1) PG8_BAR; }
    }
    PG8_WAIT_V(0);
    if constexpr (!ALIGN_EPI) { if (wr == 0) PG8_BAR; }
    PG8_BAR;
    if constexpr (Epi::AFTER_DRAIN) { E.fused(acc, cur, wr, wc, fr, fq, lds, wid, lane); S.done(cur); }
#undef PG8_SA
#undef PG8_SB
#undef PG8_STAGE
#undef PG8_LDA
#undef PG8_LDB
#undef PG8_MMA
#undef PG8_WAIT_V
#undef PG8_WAIT_L
#undef PG8_BAR
#undef PG8_SCHED
}
}

#define GAS __attribute__((address_space(1)))
#define LAS __attribute__((address_space(3)))
typedef unsigned short bf16;
typedef unsigned v4u __attribute__((ext_vector_type(4)));
typedef unsigned v2u __attribute__((ext_vector_type(2)));
typedef float f32x4 __attribute__((ext_vector_type(4)));
typedef float f32x16 __attribute__((ext_vector_type(16)));
typedef short bf16x8 __attribute__((ext_vector_type(8)));
typedef short s16x4 __attribute__((ext_vector_type(4)));
typedef GAS unsigned gu32;
#define RLX_AGENT __ATOMIC_RELAXED, __HIP_MEMORY_SCOPE_AGENT
#define LDS_WAIT() asm volatile("s_waitcnt lgkmcnt(0)" ::: "memory")
#define VM_WAIT() asm volatile("s_waitcnt vmcnt(0)" ::: "memory")

constexpr int DM = 1024, NB = 8, SEQ = 4096, CTXL = 256, DEPTH = 4;
constexpr int MX = NB * SEQ, MC = NB * CTXL, MT = MX + MC;
constexpr float ALPHA = 1.681792830507429f;
constexpr float LN_EPS = 1e-5f;
constexpr float LOG2E = 1.4426950408889634f;
constexpr float QSCALE = 0.125f * LOG2E;
constexpr int NWAVES = 8;
constexpr int NPH = 2 + 4 * DEPTH;

constexpr size_t MiB = 1u << 20;
constexpr size_t WS_CTL = 0, CTL_ZERO_BYTES = 64 * 1024;
constexpr int CW_BAR = 1024, CW_SUB = 8192;
constexpr size_t WS_MOD = 1 * MiB;
constexpr size_t WS_COS = 1 * MiB + 512 * 1024, WS_SIN = WS_COS + 4096;
constexpr size_t WS_STATS = 1 * MiB + 640 * 1024;
constexpr size_t WS_WIN = 2 * MiB;
constexpr size_t WS_WOUT = 34 * MiB;
constexpr size_t WS_XRC = 42 * MiB;
constexpr size_t WS_XN = 50 * MiB;
constexpr size_t ACT = (size_t)68 * MiB;
constexpr size_t WS_Q = 118 * MiB, WS_K = WS_Q + ACT, WS_V = WS_K + ACT, WS_Z = WS_V + ACT, WS_YZ = WS_Z + ACT, WS_END = WS_YZ + ACT;
constexpr int NAB_TINT = 65536, NAB_TB = NAB_TINT + 16 * 512, NAB_RPB = NAB_TB + 15 * 16 * 256 + 512;
constexpr int LDS_BYTES = 147456;

__device__ __forceinline__ unsigned f2bf(float f) { unsigned u = __builtin_bit_cast(unsigned, f); return (u + 0x7fffu + ((u >> 16) & 1u)) >> 16; }
__device__ __forceinline__ unsigned pk2(float lo, float hi) { return f2bf(lo) | (f2bf(hi) << 16); }
typedef float f32x2_t __attribute__((ext_vector_type(2))); typedef __bf16 bf16x2_t __attribute__((ext_vector_type(2)));
__device__ __forceinline__ unsigned cvtpk(float lo, float hi) { f32x2_t v = {lo, hi}; bf16x2_t b = __builtin_convertvector(v, bf16x2_t); return __builtin_bit_cast(unsigned, b); }
__device__ __forceinline__ float bflo(unsigned u) { return __builtin_bit_cast(float, u << 16); }
__device__ __forceinline__ float bfhi(unsigned u) { return __builtin_bit_cast(float, u & 0xffff0000u); }
__device__ __forceinline__ float wave_sum(float v) {
#pragma unroll
    for (int o = 1; o < 64; o <<= 1) v += __shfl_xor(v, o);
    return v;
}
__device__ __forceinline__ float silu_f(float v) { return v * __builtin_amdgcn_rcpf(1.f + __builtin_amdgcn_exp2f(-1.4426950408889634f * v)); }

namespace pg8 {
struct EpiIn {
    static constexpr bool PERM = true, AFTER_DRAIN = false;
    bf16_t* Q; size_t stride; int rope; const float* cosT; const float* sinT;
    __device__ __forceinline__ void operator()(const f32x4 (&acc)[2][2][4][2], const Unit& u, int wr, int wc, int fr, int fq) const {
        const int t = u.pn >> 2, colt = (u.pn & 3) * 256;
        bf16_t* base = Q + (size_t)t * stride;
        const int row0 = u.pm * BM + wr * 64 + fr, col0 = colt + wc * 32 + 8 * fq;
        const bool do_rope = rope && t < 2 && u.pm < (MX / BM);
        const int half = wc & 1, f0 = 8 * (fq & 1);
        const float sgn = (fq >> 1) ? 1.f : -1.f;
#pragma unroll
        for (int ai = 0; ai < 2; ++ai)
#pragma unroll
            for (int m = 0; m < 4; ++m) {
                const int row = row0 + ai * HALF + m * 16;
                bf16_t* rowp = (t == 3) ? base + (size_t)row * 1024 + col0 : base + ((size_t)(col0 >> 6) * MT + row) * 64 + (col0 & 63);
                f32x4 c0 = {1.f, 1.f, 1.f, 1.f}, c1 = c0, s0 = {0.f, 0.f, 0.f, 0.f}, s1 = s0;
                if (do_rope) { const int tok = row & (SEQ - 1); const int pos = half ? (tok & 63) : (tok >> 6);
                    c0 = *(const f32x4*)(cosT + pos * 16 + f0); c1 = *(const f32x4*)(cosT + pos * 16 + f0 + 4);
                    s0 = *(const f32x4*)(sinT + pos * 16 + f0) * sgn; s1 = *(const f32x4*)(sinT + pos * 16 + f0 + 4) * sgn; }
#pragma unroll
                for (int bj = 0; bj < 2; ++bj) {
                    f32x4 v0 = acc[ai][bj][m][0], v1 = acc[ai][bj][m][1];
                    if (t == 3) {
#pragma unroll
                        for (int j = 0; j < 4; ++j) { v0[j] = silu_f(v0[j]); v1[j] = silu_f(v1[j]); }
                    } else if (do_rope) {
                        f32x4 p0, p1;
#pragma unroll
                        for (int j = 0; j < 4; ++j) { p0[j] = __shfl_xor(v0[j], 32); p1[j] = __shfl_xor(v1[j], 32); }
                        v0 = v0 * c0 + p0 * s0; v1 = v1 * c1 + p1 * s1;
                    }
                    if (t == 0) { v0 = v0 * QSCALE; v1 = v1 * QSCALE; }
                    u32x4 w; w.x = cvt_pk_bf16(v0[0], v0[1]); w.y = cvt_pk_bf16(v0[2], v0[3]); w.z = cvt_pk_bf16(v1[0], v1[1]); w.w = cvt_pk_bf16(v1[2], v1[3]);
                    *(u32x4*)(rowp + (t == 3 ? bj * HALF : bj * 2 * MT * 64)) = w;
                }
            }
    }
};
struct EpiOut {
    static constexpr bool PERM = false, AFTER_DRAIN = false;
    const float* res_x; const float* res_c; float* out_x; float* out_c; const float* modl;
    const float* stats; const float* lng; const float* lnb;
    __device__ __forceinline__ void operator()(const f32x4 (&acc)[2][2][4][2], const Unit& u, int wr, int wc, int fr, int fq) const {
        const bool isc = u.pm >= (MX / BM);
        const int rbase = (isc ? u.pm - MX / BM : u.pm) * BM + wr * 64 + fr;
        const float* res = isc ? res_c : res_x; float* out = isc ? out_c : out_x;
        const int bidx = isc ? 8 : (u.pm >> 4);
        const int col0 = u.pn * BM + wc * 32 + 4 * fq;
        const float* g = modl + bidx * 3072 + 2048 + col0;
        f32x4 gv[2][2], lg[2][2], lb[2][2];
#pragma unroll
        for (int bj = 0; bj < 2; ++bj)
#pragma unroll
            for (int n = 0; n < 2; ++n) { gv[bj][n] = *(const f32x4*)(g + bj * HALF + n * 16) + 1.f;
                if (stats) { lg[bj][n] = *(const f32x4*)(lng + col0 + bj * HALF + n * 16) * ALPHA; lb[bj][n] = *(const f32x4*)(lnb + col0 + bj * HALF + n * 16) * ALPHA; }
                else { lg[bj][n] = (f32x4){ALPHA, ALPHA, ALPHA, ALPHA}; lb[bj][n] = (f32x4){0.f, 0.f, 0.f, 0.f}; } }
        const int srow0 = (isc ? MX : 0) + rbase;
#pragma unroll
        for (int ai = 0; ai < 2; ++ai)
#pragma unroll
            for (int m = 0; m < 4; ++m) { const int rr = rbase + ai * HALF + m * 16; const size_t off = (size_t)rr * 1024 + col0;
                float mean = 0.f, rstd = 1.f;
                if (stats) { const float* sp = stats + 2 * (size_t)(srow0 + ai * HALF + m * 16); mean = sp[0]; rstd = sp[1]; }
#pragma unroll
                for (int bj = 0; bj < 2; ++bj)
#pragma unroll
                    for (int n = 0; n < 2; ++n) { const f32x4 r4 = *(const f32x4*)(res + off + bj * HALF + n * 16);
                        *(f32x4*)(out + off + bj * HALF + n * 16) = ((r4 - mean) * rstd) * lg[bj][n] + lb[bj][n] + gv[bj][n] * acc[ai][bj][m][n]; }
                if (m & 1) asm volatile("" ::: "memory"); }
    }
};
}

#define MFMA32(a, b, c) __builtin_amdgcn_mfma_f32_32x32x16_bf16((a), (b), (c), 0, 0, 0)
typedef short v4i16_t __attribute__((ext_vector_type(4)));
__device__ __forceinline__ s16x4 vtr(const LAS unsigned char* p) { return __builtin_bit_cast(s16x4, __builtin_amdgcn_ds_read_tr16_b64_v4i16((LAS v4i16_t*)p)); }
__device__ __forceinline__ int crow(int r, int hi) { return (r & 3) + 8 * (r >> 2) + 4 * hi; }
__device__ __forceinline__ int clampi(int v, int lo, int hi) { return v < lo ? lo : (v > hi ? hi : v); }

__device__ __forceinline__ float max3f(float a, float b, float c) { float r; asm("v_max3_f32 %0, %1, %2, %3" : "=v"(r) : "v"(a), "v"(b), "v"(c)); return r; }
__device__ __forceinline__ void glds16(const void* gbase, unsigned voff_bytes, unsigned lds_dst) { unsigned keep;
    asm volatile("s_mov_b32 %0, m0\n\ts_mov_b32 m0, %3\n\ts_nop 0\n\tglobal_load_lds_dwordx4 %1, %2\n\ts_mov_b32 m0, %0" : "=&s"(keep) : "v"(voff_bytes), "s"(gbase), "s"(lds_dst) : "memory"); }
#define ATT_WAITBAR(N) asm volatile("s_waitcnt vmcnt(" #N ") lgkmcnt(0)\n\ts_barrier" ::: "memory")
template <int DVB, bool NA, bool SPLIT>
__device__ __forceinline__ void attn_unit(const int PROBE, const int wid_in, LAS unsigned char* lds, const bf16* Q, const bf16* Km, const bf16* Vm, const bf16* SZ, bf16* YZ,
                                          int q_row0, int qcol, int vcol, int seg1, int n1, int seg2, int n2, int kr0, bool xunit, int rq0,
                                          const LAS float* rpbL, float lam, float omli, const float* subg) {
    constexpr int KMAPS = SPLIT ? 2 : 1, KB = 8192, STAGE = KMAPS * KB + DVB * 4096, NS = 4, IPT = KMAPS + DVB / 2;
    static_assert(IPT == 2 || IPT == 4, "DMA instructions per tile per thread");
    int tid_o = wid_in * 64 + lane_id_v(); asm volatile("" : "+v"(tid_o));
    const int tid = tid_o, lane = tid & 63, wid = wid_in, r32 = lane & 31, hi = lane >> 5;
    const int NT = n1 + n2;
    const int wq_off = SPLIT ? (wid & 3) * 32 : wid * 32, wmap = SPLIT ? (wid >> 2) : 0;
    const unsigned lds0 = (unsigned)(uintptr_t)lds;
    const unsigned koff = (unsigned)((wid * 8 + (lane >> 3)) * 64 + (((lane & 7) ^ ((4 * (wid & 1) + (lane >> 4)) & 7)) * 8));
    unsigned voff[DVB / 2];
#pragma unroll
    for (int i = 0; i < DVB / 2; ++i) { const int p = wid + 8 * i, dvb = p >> 2, g8 = 2 * (p & 3) + (lane >> 5), row = g8 * 8 + ((lane & 31) >> 2);
        voff[i] = (unsigned)(((size_t)0 + (dvb >> 1)) * MT * 64 + row * 64 + (dvb & 1) * 32 + (lane & 3) * 8); }
#define ATT_ISSUE(t, slot) do { if (PROBE == 1) break; const int rb_ = (t) < n1 ? seg1 + 64 * (t) : seg2 + 64 * ((t) - n1); const unsigned sb_ = lds0 + (slot) * STAGE + wid * 1024; \
        _Pragma("unroll") for (int m_ = 0; m_ < KMAPS; ++m_) glds16(Km + ((size_t)((qcol >> 6) + m_) * MT + rb_) * 64, koff * 2u, (unsigned)__builtin_amdgcn_readfirstlane(sb_ + m_ * KB)); \
        _Pragma("unroll") for (int i_ = 0; i_ < DVB / 2; ++i_) glds16(Vm + ((size_t)(vcol >> 6) * MT + rb_) * 64, voff[i_] * 2u, (unsigned)__builtin_amdgcn_readfirstlane(sb_ + KMAPS * KB + i_ * 8192)); } while (0)
#pragma unroll
    for (int t = 0; t < 2; ++t) if (t < NT) ATT_ISSUE(t, t);
    bf16x8 qf[4];
#define ATT_QROW(j) ((NA && xunit) ? (q_row0 + ((wid >> 2) * 2 + ((j) >> 4)) * 64 + (wid & 3) * 16 + ((j) & 15)) : (q_row0 + wq_off + (j)))
    { const bf16* qp = Q + ((size_t)((qcol >> 6) + wmap) * MT + ATT_QROW(r32)) * 64 + hi * 8;
#pragma unroll
      for (int d0 = 0; d0 < 4; ++d0) qf[d0] = *(const bf16x8*)(qp + d0 * 16); }
    asm volatile("" : "+v"(qf[0]), "+v"(qf[1]), "+v"(qf[2]), "+v"(qf[3]));
    float mrun = 0.f; f32x16 o[DVB], ol, negm;
    bool seen = false;
    bool pend = false;
#pragma unroll
    for (int d = 0; d < DVB; ++d)
#pragma unroll
        for (int r = 0; r < 16; ++r) o[d][r] = 0.f;
#pragma unroll
    for (int r = 0; r < 16; ++r) { ol[r] = 0.f; negm[r] = 0.f; }
    const bf16x8 ones = {0x3f80, 0x3f80, 0x3f80, 0x3f80, 0x3f80, 0x3f80, 0x3f80, 0x3f80};
    const int rowA = rq0 + 2 * (wid >> 2), row_l = rowA + (r32 >> 4), r0_l = clampi(row_l - 4, 0, 56);
    const int r0A = clampi(rowA - 4, 0, 56), r0B = clampi(rowA - 3, 0, 56);
    const int wq = 16 * (wid & 3) + (r32 & 15);
    const int cbk = (wid & 3) == 0 ? 0 : ((wid & 3) == 1 ? 8 : ((wid & 3) == 2 ? 24 : 32));
    const bool nab_int = (wq >= 8 && wq <= 56);
    const int nab_v = wq < 8 ? wq : wq - 49;
    const int nab_base = nab_int ? (NAB_TINT + (cbk + 4 * hi - wq + 63) * 4) : (NAB_TB + nab_v * (16 * 256) + (cbk + 4 * hi) * 4);
    const int nab_stride = nab_int ? 512 : 256;
    const int kbyteW = (cbk + r32) * 128, kxW = ((cbk + r32) >> 1) & 7;
    const int kbyte = r32 * 128, kx = (r32 >> 1) & 7;
    const int vlane = (4 * hi + ((lane & 15) >> 2)) * 64 + ((lane >> 4) & 1) * 32 + (lane & 3) * 8;
    constexpr int DH = DVB / 2;
    const f32x16 zero16 = {0.f, 0.f, 0.f, 0.f, 0.f, 0.f, 0.f, 0.f, 0.f, 0.f, 0.f, 0.f, 0.f, 0.f, 0.f, 0.f};
    v4u pw[4];
#pragma unroll
    for (int j = 0; j < 4; ++j) pw[j] = (v4u){0u, 0u, 0u, 0u};
#define ATT_VREAD(vfa, dlo, dhi, vbp) do { _Pragma("unroll") for (int d_ = (dlo); d_ < (dhi); ++d_) _Pragma("unroll") for (int ks_ = 0; ks_ < 4; ++ks_) { \
        const s16x4 lo_ = vtr((vbp) + (d_ * 8 + 2 * ks_) * 512), h4_ = vtr((vbp) + (d_ * 8 + 2 * ks_ + 1) * 512); \
        vfa[d_][ks_] = (bf16x8){lo_[0], lo_[1], lo_[2], lo_[3], h4_[0], h4_[1], h4_[2], h4_[3]}; } } while (0)
#define ATT_PV2(vfa, dlo, dhi) do { _Pragma("unroll") for (int d_ = (dlo); d_ < (dhi); ++d_) _Pragma("unroll") for (int ks_ = 0; ks_ < 4; ++ks_) o[d_] = MFMA32(vfa[d_][ks_], __builtin_bit_cast(bf16x8, pw[ks_]), o[d_]); } while (0)
#define ATT_SB() __builtin_amdgcn_sched_barrier(0)
    for (int t = 0; t < NT; ++t) {
        if (NA) {
            if ((t & 1) == 0) { ATT_WAITBAR(0);
                if (t + 2 < NT) ATT_ISSUE(t + 2, (t + 2) & (NS - 1));
                if (t + 3 < NT) ATT_ISSUE(t + 3, (t + 3) & (NS - 1)); }
        } else {
        { const int rem = NT - 1 - t;
          if (IPT == 4) { if (rem >= 1) ATT_WAITBAR(4); else ATT_WAITBAR(0); }
          else          { if (rem >= 1) ATT_WAITBAR(2); else ATT_WAITBAR(0); } }
        if (t + 2 < NT) ATT_ISSUE(t + 2, (t + 2) & (NS - 1));
        }
        const bool win = NA && xunit && t < n1;
        const int kr = kr0 + t;
        const bool active = (PROBE != 2) && (!win || (kr >= r0A && kr <= r0B + 7));
        if (NA && win && active) {
            const LAS unsigned char* sb = lds + (t & (NS - 1)) * STAGE;
            const LAS unsigned char* vbw = sb + KMAPS * KB + vlane + (cbk >> 3) * 512;
            const int trow = (kr >= r0_l && kr <= r0_l + 7) ? kr - row_l + 8 : 0;
            const LAS unsigned char* tb = lds + nab_base + trow * nab_stride;
            f32x16 cbv; bf16x8 kaw[4], vfw[DVB][2];
#pragma unroll
            for (int r = 0; r < 16; ++r) cbv[r] = *(const LAS float*)(tb + 4 * ((r & 3) + 8 * (r >> 2)));
#pragma unroll
            for (int d0 = 0; d0 < 4; ++d0) kaw[d0] = *(const LAS bf16x8*)(sb + kbyteW + (((2 * d0 + hi) ^ kxW) * 16));
            ATT_SB();
#pragma unroll
            for (int d = 0; d < DVB; ++d)
#pragma unroll
                for (int ks = 0; ks < 2; ++ks) { const s16x4 lo_ = vtr(vbw + (d * 8 + 2 * ks) * 512), h4_ = vtr(vbw + (d * 8 + 2 * ks + 1) * 512);
                    vfw[d][ks] = (bf16x8){lo_[0], lo_[1], lo_[2], lo_[3], h4_[0], h4_[1], h4_[2], h4_[3]}; }
            ATT_SB();
            __builtin_amdgcn_s_setprio(1);
            f32x16 s0 = MFMA32(kaw[0], qf[0], cbv);
#pragma unroll
            for (int d0 = 1; d0 < 4; ++d0) s0 = MFMA32(kaw[d0], qf[d0], s0);
            __builtin_amdgcn_s_setprio(0);
            ATT_SB();
#pragma unroll
            for (int r = 0; r < 16; ++r) s0[r] -= mrun;
            float mx;
            { const float t0 = max3f(s0[0], s0[1], s0[2]), t1 = max3f(s0[3], s0[4], s0[5]), t2 = max3f(s0[6], s0[7], s0[8]), t3 = max3f(s0[9], s0[10], s0[11]), t4 = max3f(s0[12], s0[13], s0[14]);
              mx = max3f(max3f(t0, t1, t2), max3f(t3, t4, s0[15]), -3e38f); }
            mx = fmaxf(mx, __shfl_xor(mx, 32));
            const bool live = mx > -1e29f;
            if (__builtin_amdgcn_ballot_w64((live && !seen) || mx > 8.f) != 0ull) {
                const float dl = seen ? fmaxf(mx, 0.f) : (live ? mx : 0.f), al = seen ? __builtin_amdgcn_exp2f(-dl) : 0.f;
                mrun += dl; seen = seen || live;
#pragma unroll
                for (int r = 0; r < 16; ++r) { s0[r] -= dl; negm[r] = -mrun; ol[r] *= al; }
#pragma unroll
                for (int d = 0; d < DVB; ++d)
#pragma unroll
                    for (int r = 0; r < 16; ++r) o[d][r] *= al;
            }
#pragma unroll
            for (int r = 0; r < 16; ++r) s0[r] = __builtin_amdgcn_exp2f(s0[r]);
#pragma unroll
            for (int j = 0; j < 4; ++j) { pw[0][j] = cvtpk(s0[2 * j], s0[2 * j + 1]); pw[1][j] = cvtpk(s0[8 + 2 * j], s0[8 + 2 * j + 1]); }
            ATT_SB();
            __builtin_amdgcn_s_setprio(1);
#pragma unroll
            for (int d = 0; d < DVB; ++d)
#pragma unroll
                for (int ks = 0; ks < 2; ++ks) o[d] = MFMA32(vfw[d][ks], __builtin_bit_cast(bf16x8, pw[ks]), o[d]);
#pragma unroll
            for (int ks = 0; ks < 2; ++ks) ol = MFMA32(ones, __builtin_bit_cast(bf16x8, pw[ks]), ol);
            __builtin_amdgcn_s_setprio(0);
        } else if (!NA && active) {
            const LAS unsigned char* sb = lds + (t & (NS - 1)) * STAGE;
            const LAS unsigned char* kb_ = sb + wmap * KB + kbyte;
            const LAS unsigned char* vbp = lds + ((t ? t - 1 : 0) & (NS - 1)) * STAGE + KMAPS * KB + vlane;
            bf16x8 ka[4], kc[4], vf[DVB][4];
#pragma unroll
            for (int d0 = 0; d0 < 4; ++d0) { const int ch = ((2 * d0 + hi) ^ kx) * 16;
                ka[d0] = *(const LAS bf16x8*)(kb_ + ch); kc[d0] = *(const LAS bf16x8*)(kb_ + 4096 + ch); }
            ATT_SB();
            ATT_VREAD(vf, 0, DH, vbp);
            ATT_SB();
            __builtin_amdgcn_s_setprio(1);
            f32x16 s0 = MFMA32(ka[0], qf[0], zero16), s1 = MFMA32(kc[0], qf[0], zero16);
#pragma unroll
            for (int d0 = 1; d0 < 4; ++d0) { s0 = MFMA32(ka[d0], qf[d0], s0); s1 = MFMA32(kc[d0], qf[d0], s1); }
            __builtin_amdgcn_s_setprio(0);
            ATT_SB();
            float mx;
            { float t0 = max3f(s0[0], s0[1], s0[2]), t1 = max3f(s0[3], s0[4], s0[5]), t2 = max3f(s0[6], s0[7], s0[8]), t3 = max3f(s0[9], s0[10], s0[11]), t4 = max3f(s0[12], s0[13], s0[14]);
              float u0 = max3f(s1[0], s1[1], s1[2]), u1 = max3f(s1[3], s1[4], s1[5]), u2 = max3f(s1[6], s1[7], s1[8]), u3 = max3f(s1[9], s1[10], s1[11]), u4 = max3f(s1[12], s1[13], s1[14]);
              t0 = max3f(t0, t1, t2); t3 = max3f(t3, t4, s0[15]); u0 = max3f(u0, u1, u2); u3 = max3f(u3, u4, s1[15]);
              mx = fmaxf(max3f(t0, t3, u0), u3); }
            mx = fmaxf(mx, __shfl_xor(mx, 32));
            if (__builtin_amdgcn_ballot_w64(!seen || mx > mrun + 8.f) != 0ull) {
                { bf16x8 vfz[DVB][4]; ATT_VREAD(vfz, 0, DVB, vbp); ATT_PV2(vfz, 0, DVB);
#pragma unroll
                    for (int ks = 0; ks < 4; ++ks) ol = MFMA32(ones, __builtin_bit_cast(bf16x8, pw[ks]), ol);
#pragma unroll
                    for (int j = 0; j < 4; ++j) pw[j] = (v4u){0u, 0u, 0u, 0u}; }
                const float mn = seen ? fmaxf(mrun, mx) : mx, al = seen ? __builtin_amdgcn_exp2f(mrun - mn) : 0.f;
                mrun = mn; seen = true;
#pragma unroll
                for (int r = 0; r < 16; ++r) ol[r] *= al;
#pragma unroll
                for (int d = 0; d < DVB; ++d)
#pragma unroll
                    for (int r = 0; r < 16; ++r) o[d][r] *= al;
            }
            ATT_SB();
            v4u pwn[4];
            {
                ATT_VREAD(vf, DH, DVB, vbp);
                ATT_PV2(vf, 0, DH);
#pragma unroll
                for (int ks = 0; ks < 4; ++ks) ol = MFMA32(ones, __builtin_bit_cast(bf16x8, pw[ks]), ol);
                ATT_PV2(vf, DH, DVB);
#pragma unroll
                for (int r = 0; r < 16; ++r) { s0[r] = __builtin_amdgcn_exp2f(s0[r] - mrun); s1[r] = __builtin_amdgcn_exp2f(s1[r] - mrun); }
#pragma unroll
                for (int j = 0; j < 4; ++j) { pwn[0][j] = cvtpk(s0[2 * j], s0[2 * j + 1]); pwn[1][j] = cvtpk(s0[8 + 2 * j], s0[8 + 2 * j + 1]);
                                              pwn[2][j] = cvtpk(s1[2 * j], s1[2 * j + 1]); pwn[3][j] = cvtpk(s1[8 + 2 * j], s1[8 + 2 * j + 1]); }
#pragma unroll
                for (int g = 0; g < 8; ++g) { __builtin_amdgcn_sched_group_barrier(0x008, 1, 0); __builtin_amdgcn_sched_group_barrier(0x100, 2, 0); __builtin_amdgcn_sched_group_barrier(0x002, 1, 0); __builtin_amdgcn_sched_group_barrier(0x400, 1, 0); }
#pragma unroll
                for (int g = 0; g < 12; ++g) { __builtin_amdgcn_sched_group_barrier(0x008, 1, 0); __builtin_amdgcn_sched_group_barrier(0x002, 3, 0); __builtin_amdgcn_sched_group_barrier(0x400, 2, 0); }
            }
            ATT_SB();
#pragma unroll
            for (int j = 0; j < 4; ++j) pw[j] = pwn[j];
            pend = true;
        } else if (active) {
            const LAS unsigned char* sb = lds + (t & (NS - 1)) * STAGE;
            const LAS unsigned char* kb_ = sb + wmap * KB + kbyte;
            const LAS unsigned char* vb_ = sb + KMAPS * KB + vlane;
            bf16x8 ka[4], kc[4], vf[DVB][4];
#pragma unroll
            for (int d0 = 0; d0 < 4; ++d0) { const int ch = ((2 * d0 + hi) ^ kx) * 16;
                ka[d0] = *(const LAS bf16x8*)(kb_ + ch); kc[d0] = *(const LAS bf16x8*)(kb_ + 4096 + ch); }
            ATT_SB();
            ATT_VREAD(vf, 0, DH, vb_);
            ATT_SB();
            __builtin_amdgcn_s_setprio(1);
            f32x16 s0 = MFMA32(ka[0], qf[0], negm), s1 = MFMA32(kc[0], qf[0], negm);
#pragma unroll
            for (int d0 = 1; d0 < 4; ++d0) { s0 = MFMA32(ka[d0], qf[d0], s0); s1 = MFMA32(kc[d0], qf[d0], s1); }
            __builtin_amdgcn_s_setprio(0);
            ATT_SB();
            float mx;
            { float t0 = max3f(s0[0], s0[1], s0[2]), t1 = max3f(s0[3], s0[4], s0[5]), t2 = max3f(s0[6], s0[7], s0[8]), t3 = max3f(s0[9], s0[10], s0[11]), t4 = max3f(s0[12], s0[13], s0[14]);
              float u0 = max3f(s1[0], s1[1], s1[2]), u1 = max3f(s1[3], s1[4], s1[5]), u2 = max3f(s1[6], s1[7], s1[8]), u3 = max3f(s1[9], s1[10], s1[11]), u4 = max3f(s1[12], s1[13], s1[14]);
              t0 = max3f(t0, t1, t2); t3 = max3f(t3, t4, s0[15]); u0 = max3f(u0, u1, u2); u3 = max3f(u3, u4, s1[15]);
              mx = fmaxf(max3f(t0, t3, u0), u3); }
            mx = fmaxf(mx, __shfl_xor(mx, 32));
            if (__builtin_amdgcn_ballot_w64(!seen || mx > 8.f) != 0ull) {
                const float dl = seen ? fmaxf(mx, 0.f) : mx, al = seen ? __builtin_amdgcn_exp2f(-dl) : 0.f;
                mrun += dl; seen = true;
#pragma unroll
                for (int r = 0; r < 16; ++r) { s0[r] -= dl; s1[r] -= dl; negm[r] = -mrun; ol[r] *= al; }
#pragma unroll
                for (int d = 0; d < DVB; ++d)
#pragma unroll
                    for (int r = 0; r < 16; ++r) o[d][r] *= al;
            }
#pragma unroll
            for (int r = 0; r < 16; ++r) { s0[r] = __builtin_amdgcn_exp2f(s0[r]); s1[r] = __builtin_amdgcn_exp2f(s1[r]); }
#pragma unroll
            for (int j = 0; j < 4; ++j) { pw[0][j] = cvtpk(s0[2 * j], s0[2 * j + 1]); pw[1][j] = cvtpk(s0[8 + 2 * j], s0[8 + 2 * j + 1]);
                                          pw[2][j] = cvtpk(s1[2 * j], s1[2 * j + 1]); pw[3][j] = cvtpk(s1[8 + 2 * j], s1[8 + 2 * j + 1]); }
            ATT_SB();
            ATT_VREAD(vf, DH, DVB, vb_);
            ATT_SB();
            __builtin_amdgcn_s_setprio(1);
            ATT_PV2(vf, 0, DH);
#pragma unroll
            for (int ks = 0; ks < 4; ++ks) ol = MFMA32(ones, __builtin_bit_cast(bf16x8, pw[ks]), ol);
            ATT_PV2(vf, DH, DVB);
            __builtin_amdgcn_s_setprio(0);
        }
    }
    if (!NA) { const LAS unsigned char* vbp = lds + ((NT - 1) & (NS - 1)) * STAGE + KMAPS * KB + vlane;
        bf16x8 vfz[DVB][4]; ATT_VREAD(vfz, 0, DVB, vbp); ATT_PV2(vfz, 0, DVB);
#pragma unroll
        for (int ks = 0; ks < 4; ++ks) ol = MFMA32(ones, __builtin_bit_cast(bf16x8, pw[ks]), ol); }
    const float lrun = ol[0];
#undef ATT_VREAD
#undef ATT_PV2
#undef ATT_SB
#undef ATT_ISSUE
    ATT_WAITBAR(0);
    if (!SPLIT) {
        const float inv = 1.f / lrun;
        LAS unsigned char* stg = lds + 2 * STAGE + wid * (32 * DVB * 64);
#pragma unroll
        for (int d = 0; d < DVB; ++d)
#pragma unroll
            for (int i = 0; i < 4; ++i) { const int ch = d * 4 + i;
                v2u w; w.x = cvtpk(o[d][4 * i] * inv, o[d][4 * i + 1] * inv); w.y = cvtpk(o[d][4 * i + 2] * inv, o[d][4 * i + 3] * inv);
                *(LAS v2u*)(stg + r32 * (DVB * 64) + ((ch ^ (r32 & (DVB * 4 - 1))) * 16) + 8 * hi) = w; }
        constexpr int CPR = DVB * 4, RPP = 64 / CPR;
#pragma unroll
        for (int p = 0; p < 32 / RPP; ++p) { const int row = p * RPP + lane / CPR, ch = lane % CPR;
            const v4u y = *(const LAS v4u*)(stg + row * (DVB * 64) + ((ch ^ (row & (CPR - 1))) * 16));
            const size_t go = (size_t)ATT_QROW(row) * 1024 + vcol + ch * 8;
            const v4u z = *(const v4u*)(SZ + go);
            v4u w; w.x = cvtpk(bflo(y.x) * bflo(z.x), bfhi(y.x) * bfhi(z.x)); w.y = cvtpk(bflo(y.y) * bflo(z.y), bfhi(y.y) * bfhi(z.y));
            w.z = cvtpk(bflo(y.z) * bflo(z.z), bfhi(y.z) * bfhi(z.z)); w.w = cvtpk(bflo(y.w) * bflo(z.w), bfhi(y.w) * bfhi(z.w));
            *(v4u*)(YZ + go) = w; }
    } else {
        LAS float* ex = (LAS float*)lds + (wid & 3) * (DVB * 16 * 64) + lane;
        const float inv = (wmap ? lam : 1.f) / lrun;
        if (wmap) {
#pragma unroll
            for (int d = 0; d < DVB; ++d)
#pragma unroll
                for (int r = 0; r < 16; ++r) ex[(d * 16 + r) * 64] = o[d][r] * inv;
        }
        __syncthreads();
        if (!wmap) {
            float ss = 0.f;
#pragma unroll
            for (int d = 0; d < DVB; ++d)
#pragma unroll
                for (int r = 0; r < 16; ++r) { const float tv = o[d][r] * inv - ex[(d * 16 + r) * 64]; o[d][r] = tv; ss += tv * tv; }
            ss += __shfl_xor(ss, 32);
            const float rn = rsqrtf(ss * (1.f / (32.f * DVB)) + LN_EPS) * omli;
            LAS unsigned char* stg = lds + 2 * STAGE + (wid & 3) * (32 * DVB * 64);
#pragma unroll
            for (int d = 0; d < DVB; ++d)
#pragma unroll
                for (int i = 0; i < 4; ++i) { const int ch = d * 4 + i, dv0 = d * 32 + 8 * i + 4 * hi;
                    const f32x4 g4 = *(const f32x4*)(subg + dv0) * rn;
                    v2u w; w.x = cvtpk(o[d][4 * i] * g4[0], o[d][4 * i + 1] * g4[1]); w.y = cvtpk(o[d][4 * i + 2] * g4[2], o[d][4 * i + 3] * g4[3]);
                    *(LAS v2u*)(stg + r32 * (DVB * 64) + ((ch ^ (r32 & (DVB * 4 - 1))) * 16) + 8 * hi) = w; }
            constexpr int CPR = DVB * 4, RPP = 64 / CPR;
#pragma unroll
            for (int p = 0; p < 32 / RPP; ++p) { const int row = p * RPP + lane / CPR, ch = lane % CPR;
                const v4u y = *(const LAS v4u*)(stg + row * (DVB * 64) + ((ch ^ (row & (CPR - 1))) * 16));
                const size_t go = (size_t)ATT_QROW(row) * 1024 + vcol + ch * 8;
                const v4u z = *(const v4u*)(SZ + go);
                v4u w; w.x = cvtpk(bflo(y.x) * bflo(z.x), bfhi(y.x) * bfhi(z.x)); w.y = cvtpk(bflo(y.y) * bflo(z.y), bfhi(y.y) * bfhi(z.y));
                w.z = cvtpk(bflo(y.z) * bflo(z.z), bfhi(y.z) * bfhi(z.z)); w.w = cvtpk(bflo(y.w) * bflo(z.w), bfhi(y.w) * bfhi(z.w));
                *(v4u*)(YZ + go) = w; }
        }
        __syncthreads();
    }
}

#define XB_TMO      128
#define XB_XCNT(j)  (256  + 64 * (j))
#define XB_XSUB(j)  (1280 + 64 * (j))
#define XB_XGEN(j)  (2304 + 64 * (j))
#define XB_TOP      3328
#define XB_TOPGEN   3392
#define XCD_BAR_WORDS 3456
#define XB_SPIN_CAP (1u << 18)

__device__ __forceinline__ unsigned xb_ld(unsigned* p)              { return __hip_atomic_load(p, __ATOMIC_RELAXED, __HIP_MEMORY_SCOPE_AGENT); }
__device__ __forceinline__ unsigned xb_add(unsigned* p, unsigned v) { return __hip_atomic_fetch_add(p, v, __ATOMIC_RELAXED, __HIP_MEMORY_SCOPE_AGENT); }
__device__ __forceinline__ unsigned xb_xcc_id() { return (unsigned)__builtin_amdgcn_s_getreg((3 << 11) | 20) & 0xFu; }
#define XB_SPIN(cond, bar) do { unsigned _sp = 0; while (cond) { __builtin_amdgcn_s_sleep(1); \
    if ((++_sp & 255u) == 0u) { if (xb_ld(&(bar)[XB_TMO])) break; if (_sp > XB_SPIN_CAP) { atomicAdd(&(bar)[XB_TMO], 1u); break; } } } } while (0)

struct XcdBarrier {
    unsigned* bar; unsigned x;
    volatile LAS unsigned* st;
};

__device__ __forceinline__ XcdBarrier xcd_barrier_post(unsigned* bar, volatile LAS unsigned* st) {
    XcdBarrier b; b.bar = bar; b.x = xb_xcc_id(); b.st = st;
    if (threadIdx.x == 0) (void)xb_add(&bar[XB_XCNT(b.x)], 1u);
    return b;
}
__device__ __forceinline__ void xcd_barrier_complete(unsigned* bar, unsigned x, unsigned& nloc, unsigned& nx) {
    const unsigned G = gridDim.x * gridDim.y * gridDim.z;
    unsigned sum, cnt, mine, sp = 0u;
    for (;;) {
        sum = 0u; cnt = 0u; mine = 0u;
#pragma unroll
        for (unsigned j = 0; j < 16; ++j) { const unsigned c = xb_ld(&bar[XB_XCNT(j)]); sum += c; cnt += (c > 0u) ? 1u : 0u; mine = (j == x) ? c : mine; }
        if (sum == G) break;
        __builtin_amdgcn_s_sleep(1);
        if ((++sp & 255u) == 0u) { if (xb_ld(&bar[XB_TMO])) break; if (sp > XB_SPIN_CAP) { atomicAdd(&bar[XB_TMO], 1u); break; } }
    }
    nloc = mine > 0u ? mine : 1u; nx = cnt > 0u ? cnt : 1u;
}

__device__ __forceinline__ void xcd_barrier(const XcdBarrier& b) {
    asm volatile("s_waitcnt vmcnt(0)" ::: "memory");
    __syncthreads();
    if (threadIdx.x == 0) {
        unsigned* bar = b.bar;
        __builtin_amdgcn_s_waitcnt(0);
        unsigned nloc = b.st[0], nx = b.st[1];
        if (nloc == 0u) { xcd_barrier_complete(bar, b.x, nloc, nx); b.st[0] = nloc; b.st[1] = nx; }
        const unsigned old = xb_add(&bar[XB_XSUB(b.x)], 1u);
        const unsigned gen = old / nloc;
        if (old + 1u == (gen + 1u) * nloc) {
            __builtin_amdgcn_fence(__ATOMIC_RELEASE, "agent");
            asm volatile("s_waitcnt vmcnt(0)" ::: "memory");
            const unsigned og = xb_add(&bar[XB_TOP], 1u);
            const unsigned tg = og / nx;
            if (og + 1u == (tg + 1u) * nx) xb_add(&bar[XB_TOPGEN], 1u);
            else XB_SPIN(xb_ld(&bar[XB_TOPGEN]) == tg, bar);
            __builtin_amdgcn_fence(__ATOMIC_ACQUIRE, "agent");
            xb_add(&bar[XB_XGEN(b.x)], 1u);
            asm volatile("s_waitcnt vmcnt(0)" ::: "memory");
        } else {
            XB_SPIN(xb_ld(&bar[XB_XGEN(b.x)]) == gen, bar);
            __builtin_amdgcn_fence(__ATOMIC_ACQUIRE, "agent");
            asm volatile("s_waitcnt vmcnt(0)" ::: "memory");
        }
    }
    __syncthreads();
}
__device__ __forceinline__ void p0_transpose_item(const float* W, int K, int N, bf16* WT, int row_off, LAS float* scr, int item, int lane) {
    const int nblk = N / 32, kb = item / nblk, nb = item % nblk, k0 = 64 * kb, n0 = 32 * nb;
    float wv[32];
#pragma unroll
    for (int i = 0; i < 32; ++i) { const int kk = 2 * i + (lane >> 5); wv[i] = W[(size_t)(k0 + kk) * N + n0 + (lane & 31)]; }
#pragma unroll
    for (int i = 0; i < 32; ++i) { const int kk = 2 * i + (lane >> 5); scr[kk * 33 + (lane & 31)] = wv[i]; }
    LDS_WAIT(); asm volatile("" ::: "memory");
    const int c = lane & 7;
#pragma unroll
    for (int j = 0; j < 4; ++j) { const int n = (lane >> 3) + 8 * j; const LAS float* s = scr + (8 * c) * 33 + n;
        v4u o; o.x = pk2(s[0 * 33], s[1 * 33]); o.y = pk2(s[2 * 33], s[3 * 33]); o.z = pk2(s[4 * 33], s[5 * 33]); o.w = pk2(s[6 * 33], s[7 * 33]);
        *(GAS v4u*)(WT + (size_t)(row_off + n0 + n) * K + k0 + 8 * c) = o; }
    LDS_WAIT(); asm volatile("" ::: "memory");
}

__device__ __forceinline__ void sincos_d(double x, double& s, double& c) {
    const double n = __builtin_rint(x * 0.63661977236758134308);
    const double r = (x - n * 1.57079632679489655800) - n * 6.12323399573676603587e-17;
    const double r2 = r * r;
    double sp = -7.6471637318198164759e-13; sp = sp * r2 + 1.6059043836821614599e-10; sp = sp * r2 - 2.5052108385441718775e-08; sp = sp * r2 + 2.7557319223985890653e-06;
    sp = sp * r2 - 1.9841269841269841270e-04; sp = sp * r2 + 8.3333333333333333333e-03; sp = sp * r2 - 1.6666666666666666667e-01; sp = r + r * r2 * sp;
    double cp = 4.7794773323873852974e-14; cp = cp * r2 - 1.1470745597729724714e-11; cp = cp * r2 + 2.0876756987868098979e-09; cp = cp * r2 - 2.7557319223985890653e-07;
    cp = cp * r2 + 2.4801587301587301587e-05; cp = cp * r2 - 1.3888888888888888889e-03; cp = cp * r2 + 4.1666666666666666667e-02; cp = cp * r2 - 0.5; cp = 1.0 + r2 * cp;
    const int q = ((int)n) & 3;
    s = (q == 0) ? sp : (q == 1) ? cp : (q == 2) ? -sp : -cp;
    c = (q == 0) ? cp : (q == 1) ? -sp : (q == 2) ? -cp : sp;
}

struct OneUnit { int pm, pn;
    __device__ __forceinline__ bool next(int i, pg8::Unit& u) const { if (i) return false; u.pm = pm; u.pn = pn; return true; }
    __device__ __forceinline__ void a_ready(const pg8::Unit&) const {}
    __device__ __forceinline__ void done(const pg8::Unit&) const {} };
__device__ __forceinline__ void sub_barrier(unsigned* ctr, unsigned target, int tid) {
    asm volatile("s_waitcnt vmcnt(0)" ::: "memory"); __syncthreads();
    if (tid == 0) {
        __builtin_amdgcn_fence(__ATOMIC_RELEASE, "agent"); asm volatile("s_waitcnt vmcnt(0)" ::: "memory");
        __hip_atomic_fetch_add(ctr, 1u, __ATOMIC_RELAXED, __HIP_MEMORY_SCOPE_AGENT);
        unsigned sp = 0;
        while (__hip_atomic_load(ctr, __ATOMIC_RELAXED, __HIP_MEMORY_SCOPE_AGENT) < target) { __builtin_amdgcn_s_sleep(2); if (++sp > (1u << 22)) break; }
        __builtin_amdgcn_fence(__ATOMIC_ACQUIRE, "agent"); asm volatile("s_waitcnt vmcnt(0)" ::: "memory");
    }
    __syncthreads();
}
constexpr int NCW = 32;
struct Args { const float* in[13]; float* out; unsigned char* ws; int ph_lo, ph_hi; };

__global__ void __launch_bounds__(NWAVES * 64, 2) fwd_kernel(Args args) {
    extern __shared__ __attribute__((aligned(16))) unsigned char lds_raw[];
    LAS unsigned char* lds = (LAS unsigned char*)lds_raw;
    cg::grid_group grid = cg::this_grid();
    const int tid0 = threadIdx.x, wave = __builtin_amdgcn_readfirstlane(tid0 >> 6);
#define OPAQUE_TID() int tid = wave * 64 + lane_id_v(); asm volatile("" : "+v"(tid)); const int lane = tid & 63
    const int G = gridDim.x, bx = blockIdx.x;
    const int vcu = (G % 8 == 0) ? (bx % 8) * (G / 8) + bx / 8 : bx;
    const int gw = vcu * NWAVES + wave, NGW = G * NWAVES;
    unsigned char* ws = args.ws;
    const float* x_in = args.in[0]; const float* c_in = args.in[1]; const float* ctx_in = args.in[2]; const float* cctx_in = args.in[3];
    const float* w_mod = args.in[4]; const float* b_mod = args.in[5]; const float* w_in = args.in[6]; const float* w_out = args.in[7];
    const float* ln_g = args.in[8]; const float* ln_b = args.in[9]; const float* na_rpb = args.in[10]; const float* diff_lambda = args.in[11]; const float* diff_subln = args.in[12];
    float* statsB = (float*)(ws + WS_STATS); float* modT = (float*)(ws + WS_MOD); float* cosT = (float*)(ws + WS_COS); float* sinT = (float*)(ws + WS_SIN);
    bf16* Win_t = (bf16*)(ws + WS_WIN); bf16* Wout_t = (bf16*)(ws + WS_WOUT);
    float* XRx = args.out; float* XRc = (float*)(ws + WS_XRC);
    bf16* XN = (bf16*)(ws + WS_XN); bf16* Qb = (bf16*)(ws + WS_Q); bf16* Kb = (bf16*)(ws + WS_K); bf16* Vb = (bf16*)(ws + WS_V); bf16* Zb = (bf16*)(ws + WS_Z); bf16* YZ = (bf16*)(ws + WS_YZ);
    const int lo = args.ph_lo, hi_ph = args.ph_hi;
    volatile LAS unsigned* MISC = (volatile LAS unsigned*)(lds + LDS_BYTES - 256);
    if (tid0 < 64) MISC[tid0] = 0u;
    __syncthreads();
    XcdBarrier bar = xcd_barrier_post((unsigned*)(args.ws + WS_CTL) + CW_BAR, MISC + 8);
#define IN_PH(k) (lo <= (k) && (k) < hi_ph)
#define SEAM(k) do { if (lo <= (k) && (k) + 1 < hi_ph) xcd_barrier(bar); } while (0)
    if (lo < 0) grid.sync();

    if (IN_PH(0)) for (int rep0_ = 0; rep0_ < REP_P0; ++rep0_) {
        OPAQUE_TID();
        if (rep0_) __syncthreads();
        LAS float* scr = (LAS float*)(lds + wave * 16384);
        constexpr int PER_L = 2048 + 512, NIT = DEPTH * PER_L;
        for (int it = gw; it < NIT; it += NGW) {
            const int l = it / PER_L, r = it % PER_L;
            if (r < 2048) p0_transpose_item(w_in + (size_t)l * 1024 * 4096, 1024, 4096, Win_t + (size_t)l * 4096 * 1024, 0, scr, r, lane);
            else p0_transpose_item(w_out + (size_t)l * 1024 * 1024, 1024, 1024, Wout_t + (size_t)l * 1024 * 1024, 0, scr, r - 2048, lane);
        }
        { const int gt = bx * (NWAVES * 64) + tid;
          if (gt < 1024) { const float invf[16] = {1.0f, 0.5623413324356079f, 0.3162277638912201f, 0.17782793939113617f, 0.10000000149011612f, 0.05623413249850273f, 0.03162277489900589f, 0.017782794311642647f,
                                                   0.009999999776482582f, 0.005623413249850273f, 0.003162277629598975f, 0.0017782794311642647f, 0.0010000000474974513f, 0.000562341301701963f, 0.0003162277571391314f, 0.00017782794020604342f};
              const int pos = gt >> 4, f = gt & 15; float fv = invf[0];
#pragma unroll
              for (int q = 1; q < 16; ++q) fv = (f == q) ? invf[q] : fv;
              const float ang = (float)pos * fv; double s, c; sincos_d((double)ang, s, c); cosT[gt] = (float)c; sinT[gt] = (float)s; } }
        __syncthreads();
        LAS float* sil = (LAS float*)lds;
        LAS float* red = sil + 9 * 1024;
        for (int i = tid; i < 9 * 1024; i += NWAVES * 64) { const int j = i >> 10, k = i & 1023; const float cv = j < 8 ? c_in[j * 1024 + k] : cctx_in[k]; sil[i] = cv / (1.f + expf(-cv)); }
        __syncthreads();
        for (int item = bx; item < DEPTH * 48; item += G) {
            const int l = item / 48, cb = item % 48;
            const float* W = w_mod + (size_t)l * 1024 * 3072 + cb * 64 + lane;
            float a0 = 0.f, a1 = 0.f, a2 = 0.f, a3 = 0.f, a4 = 0.f, a5 = 0.f, a6 = 0.f, a7 = 0.f, a8 = 0.f;
#pragma unroll 32
            for (int kk = 0; kk < 128; ++kk) { const int k = wave * 128 + kk; const float wv = W[(size_t)k * 3072];
                a0 += sil[k] * wv; a1 += sil[1024 + k] * wv; a2 += sil[2048 + k] * wv; a3 += sil[3072 + k] * wv; a4 += sil[4096 + k] * wv;
                a5 += sil[5120 + k] * wv; a6 += sil[6144 + k] * wv; a7 += sil[7168 + k] * wv; a8 += sil[8192 + k] * wv; }
            LAS float* rw = red + wave * 9 * 64 + lane;
            rw[0] = a0; rw[64] = a1; rw[128] = a2; rw[192] = a3; rw[256] = a4; rw[320] = a5; rw[384] = a6; rw[448] = a7; rw[512] = a8;
            __syncthreads();
            for (int i = tid; i < 9 * 64; i += NWAVES * 64) { const int j = i >> 6, cc = i & 63; float s = b_mod[l * 3072 + cb * 64 + cc];
#pragma unroll
                for (int w = 0; w < 8; ++w) s += red[(w * 9 + j) * 64 + cc];
                modT[(size_t)(l * 9 + j) * 3072 + cb * 64 + cc] = s; }
            __syncthreads();
        }
    }
    SEAM(0);

    for (int l = 0; l < DEPTH; ++l) {
        const bool need_ctx = l < DEPTH - 1;
        if (IN_PH(1 + 4 * l)) for (int repa_ = 0; repa_ < REP_A; ++repa_) {
            OPAQUE_TID(); const float* modl = modT + (size_t)l * 9 * 3072;
            const bool side = (l > 0) && (G > 2 * NCW);
            int row_lo = gw, row_hi = MT, row_st = NGW;
            if (side) {
                if (bx < NCW) {
                    const int lp = l - 1; const float* modp = modT + (size_t)lp * 9 * 3072;
                    pg8::Gemm g{YZ, Wout_t + (size_t)lp * 1024 * 1024, MT, 1024, 1024}; OneUnit S{MX / 256 + (bx >> 2), bx & 3};
                    pg8::EpiOut E{lp == 0 ? x_in : XRx, lp == 0 ? ctx_in : XRc, XRx, XRc, modp, lp == 0 ? nullptr : statsB, ln_g + (lp - 1) * 1024, ln_b + (lp - 1) * 1024};
                    pg8::gemm_phase<pg8::EpiOut, OneUnit, true, true>(lds, g, S, E, wave);
                    sub_barrier((unsigned*)(ws + WS_CTL) + CW_SUB, (unsigned)(NCW * l), tid);
                    row_lo = MX + bx * NWAVES + wave; row_hi = MT; row_st = NCW * NWAVES;
                } else { row_lo = (bx - NCW) * NWAVES + wave; row_hi = MX; row_st = (G - NCW) * NWAVES; }
            }
            constexpr int RB = 4;
            for (int row0 = row_lo; row0 < row_hi; row0 += RB * row_st) {
                f32x4 v[RB][4];
#pragma unroll
                for (int u = 0; u < RB; ++u) { const int row = row0 + u * row_st; const int rowc = row < row_hi ? row : row0;
                    const bool isc = rowc >= MX; const int rr = isc ? rowc - MX : rowc;
                    const float* src = (l == 0) ? (isc ? ctx_in : x_in) : (isc ? XRc : XRx);
                    const GAS f32x4* xr = (const GAS f32x4*)(src + (size_t)rr * 1024) + lane;
#pragma unroll
                    for (int j = 0; j < 4; ++j) v[u][j] = xr[64 * j]; }
#pragma unroll
                for (int u = 0; u < RB; ++u) { const int row = row0 + u * row_st; if (row >= row_hi) break;
                    const bool isc = row >= MX;
                    if (l > 0) {
                        float s = 0.f;
#pragma unroll
                        for (int j = 0; j < 4; ++j) s += (v[u][j].x + v[u][j].y) + (v[u][j].z + v[u][j].w);
                        const float mean = wave_sum(s) * (1.f / 1024.f); float s2 = 0.f;
#pragma unroll
                        for (int j = 0; j < 4; ++j) { v[u][j] = v[u][j] - mean; s2 += (v[u][j].x * v[u][j].x + v[u][j].y * v[u][j].y) + (v[u][j].z * v[u][j].z + v[u][j].w * v[u][j].w); }
                        const float rstd = 1.f / sqrtf(wave_sum(s2) * (1.f / 1024.f) + LN_EPS);
                        if (lane == 0) { float* sp = statsB + 2 * (size_t)row; sp[0] = mean; sp[1] = rstd; }
#pragma unroll
                        for (int j = 0; j < 4; ++j) { const f32x4 g4 = *((const f32x4*)(ln_g + (l - 1) * 1024) + lane + 64 * j), b4 = *((const f32x4*)(ln_b + (l - 1) * 1024) + lane + 64 * j);
                            v[u][j] = v[u][j] * rstd * g4 + b4; }
                    }
                    const float* mrow = modl + (isc ? 8 : (row >> 12)) * 3072;
                    GAS v2u* o8 = (GAS v2u*)(XN + (size_t)row * 1024) + lane;
#pragma unroll
                    for (int j = 0; j < 4; ++j) { const f32x4 sh = *((const f32x4*)mrow + lane + 64 * j), sc = *((const f32x4*)(mrow + 1024) + lane + 64 * j);
                        const f32x4 h = v[u][j] * (sc + 1.f) + sh; v2u w; w.x = cvtpk(h.x, h.y); w.y = cvtpk(h.z, h.w); o8[64 * j] = w; }
                }
            }
        }
        SEAM(1 + 4 * l);
        if (IN_PH(2 + 4 * l)) for (int rep_ = 0; rep_ < REP_B; ++rep_) {
            pg8::Gemm g{XN, Win_t + (size_t)l * 4096 * 1024, MT, 4096, 1024}; pg8::StaticOrder S; S.init(MT, 4096, G, bx);
            pg8::EpiIn E{Qb, ACT / 2, l & 1, cosT, sinT};
            pg8::gemm_phase<pg8::EpiIn, pg8::StaticOrder, true, true>(lds, g, S, E, wave);
        }
        SEAM(2 + 4 * l);
        if (IN_PH(3 + 4 * l)) {
            OPAQUE_TID();
#ifndef NO_NA
            if ((l & 1) == 0) for (int rep_ = 0; rep_ < REP_NA; ++rep_) {
                LAS float* rpbL = (LAS float*)(lds + NAB_RPB);
                const float* rpb = na_rpb + (size_t)(l >> 1) * 16 * 15 * 31;
                constexpr int NXU = NB * 16 * 16; const int per = (NXU + G - 1) / G;
                int hl = -1;
                const bool xl = (G == 256);
                for (int i = 0; i < per; ++i) { const int u = vcu * per + i; if (u >= NXU) break;
                    const int bh = xl ? (i * 16 + 2 * (vcu >> 5) + ((vcu >> 4) & 1)) : (u >> 4), rq = xl ? (vcu & 15) : (u & 15), b = bh >> 4, h = bh & 15, rlo = 4 * rq;
                    const int kr0 = clampi(rlo - 4, 0, 56), n1 = clampi(rlo - 1, 0, 56) + 8 - kr0;
                    if (h != hl) {
                        for (int q = tid; q < 15 * 31; q += NWAVES * 64) rpbL[q] = rpb[h * 465 + q] * LOG2E;
                        __syncthreads();
                        LAS float* tint = (LAS float*)(lds + NAB_TINT); LAS float* tb = (LAS float*)(lds + NAB_TB);
                        for (int q = tid; q < 16 * 128; q += NWAVES * 64) { const int tr = q >> 7, dc = (q & 127) - 48; tint[q] = (tr >= 1 && dc >= 7 && dc <= 22) ? rpbL[(tr - 1) * 31 + dc] : -1e30f; }
                        for (int q = tid; q < 15 * 16 * 64; q += NWAVES * 64) { const int v = q >> 10, rem = q & 1023, tr = rem >> 6, kc = rem & 63, w = v < 8 ? v : v + 49;
                            const int c0 = clampi(w - 8, 0, 48), dc = kc - w + 15; tb[q] = (tr >= 1 && kc >= c0 && kc <= c0 + 15) ? rpbL[(tr - 1) * 31 + dc] : -1e30f; }
                        hl = h; }
                    attn_unit<2, true, false>((PROBE_NA && rep_ == 0) ? PROBE_NA : 0, wave, lds, Qb, Kb, Vb, Zb, (PROBE_NA && rep_ == 0) ? XN : YZ, b * SEQ + rlo * 64, h * 64, h * 64, b * SEQ + kr0 * 64, n1, MX + b * CTXL, 4, kr0, true, rlo, rpbL, 0.f, 0.f, nullptr);
                }
                if (need_ctx) for (int u = vcu; u < NB * 16; u += G) { const int b = u >> 4, h = u & 15;
                    attn_unit<2, true, false>(0, wave, lds, Qb, Kb, Vb, Zb, YZ, MX + b * CTXL, h * 64, h * 64, 0, 0, MX + b * CTXL, 4, 0, false, 0, rpbL, 0.f, 0.f, nullptr); }
            }
#endif
#ifndef NO_DIFF
            if ((l & 1) == 1) for (int rep_ = 0; rep_ < REP_DIFF; ++rep_) {
                const float li = (l == 1) ? 0.35550906759096934f : 0.5560582041556406f;
                const float* lp = diff_lambda + (size_t)(l >> 1) * 256;
                const float sa = wave_sum(lp[lane] * lp[64 + lane]), sb = wave_sum(lp[128 + lane] * lp[192 + lane]);
                const float lam = expf(sa) - expf(sb) + li;
                const float* subg = diff_subln + (size_t)(l >> 1) * 128;
                constexpr int NXU = NB * 8 * 32; const int per = (NXU + G - 1) / G;
                const bool xl = (G == 256);
                for (int i = 0; i < per; ++i) { const int u = vcu * per + i; if (u >= NXU) break;
                    const int bh = xl ? ((vcu >> 5) * 8 + i) : (u >> 5), qb = xl ? (vcu & 31) : (u & 31), b = bh >> 3, h = bh & 7;
                    attn_unit<4, false, true>((PROBE_DIFF && rep_ == 0) ? PROBE_DIFF : 0, wave, lds, Qb, Kb, Vb, Zb, (PROBE_DIFF && rep_ == 0) ? XN : YZ, b * SEQ + qb * 128, h * 128, h * 128, b * SEQ, 64, MX + b * CTXL, 4, 0, true, 0, nullptr, lam, 1.f - li, subg);
                }
                if (need_ctx) for (int u = vcu; u < NB * 8 * 2; u += G) { const int b = u >> 4, h = (u >> 1) & 7, qh = u & 1;
                    attn_unit<4, false, true>(0, wave, lds, Qb, Kb, Vb, Zb, YZ, MX + b * CTXL + qh * 128, h * 128, h * 128, 0, 0, MX + b * CTXL, 4, 0, false, 0, nullptr, lam, 1.f - li, subg); }
            }
#endif
        }
        SEAM(3 + 4 * l);
        if (IN_PH(4 + 4 * l)) {
            const float* modl = modT + (size_t)l * 9 * 3072;
            const int Mo = (need_ctx && !(G > 2 * NCW)) ? MT : MX;
            pg8::Gemm g{YZ, Wout_t + (size_t)l * 1024 * 1024, Mo, 1024, 1024}; pg8::StaticOrder S; S.init(Mo, 1024, G, bx);
            for (int repd_ = 0; repd_ < REP_D; ++repd_) {
            pg8::EpiOut E{l == 0 ? x_in : XRx, l == 0 ? ctx_in : XRc, (repd_ + 1 < REP_D) ? (float*)Qb : XRx, XRc, modl, l == 0 ? nullptr : statsB, ln_g + (l - 1) * 1024, ln_b + (l - 1) * 1024};
            pg8::gemm_phase<pg8::EpiOut, pg8::StaticOrder, true, true>(lds, g, S, E, wave);
            }
        }
        SEAM(4 + 4 * l);
    }
    if (IN_PH(NPH - 1)) {
        OPAQUE_TID();
        constexpr int RB = 4;
        for (int row0 = gw; row0 < MX; row0 += RB * NGW) {
            f32x4 v[RB][4];
#pragma unroll
            for (int u = 0; u < RB; ++u) { const int row = row0 + u * NGW; const int rowc = row < MX ? row : row0;
                const GAS f32x4* xr = (const GAS f32x4*)(XRx + (size_t)rowc * 1024) + lane;
#pragma unroll
                for (int j = 0; j < 4; ++j) v[u][j] = xr[64 * j]; }
#pragma unroll
            for (int u = 0; u < RB; ++u) { const int row = row0 + u * NGW; if (row >= MX) break;
                GAS f32x4* xo = (GAS f32x4*)(XRx + (size_t)row * 1024) + lane;
                float s = 0.f;
#pragma unroll
                for (int j = 0; j < 4; ++j) s += (v[u][j].x + v[u][j].y) + (v[u][j].z + v[u][j].w);
                const float mean = wave_sum(s) * (1.f / 1024.f); float s2 = 0.f;
#pragma unroll
                for (int j = 0; j < 4; ++j) { v[u][j] = v[u][j] - mean; s2 += (v[u][j].x * v[u][j].x + v[u][j].y * v[u][j].y) + (v[u][j].z * v[u][j].z + v[u][j].w * v[u][j].w); }
                const float rstd = 1.f / sqrtf(wave_sum(s2) * (1.f / 1024.f) + LN_EPS);
#pragma unroll
                for (int j = 0; j < 4; ++j) { const f32x4 g4 = *((const f32x4*)(ln_g + 3 * 1024) + lane + 64 * j), b4 = *((const f32x4*)(ln_b + 3 * 1024) + lane + 64 * j);
                    xo[64 * j] = v[u][j] * rstd * g4 + b4; }
            }
        }
    }
#undef IN_PH
#undef SEAM
}

#ifndef N_LAUNCH_MODE_GUARD_DUMMY
#endif
#ifndef N_LAUNCH_MODE
#define N_LAUNCH_MODE 1
#endif
extern "C" void kernel_launch(void* const* d_in, const int* in_sizes, int n_in, void* d_out, int out_size, void* d_ws, size_t ws_size, hipStream_t stream) {
    static int grid = 0;
    if (grid == 0) {
        if (n_in != 13 || out_size != MX * DM || ws_size < WS_END) { fprintf(stderr, "kernel_launch: unexpected shapes (n_in %d out %d ws %zu)\n", n_in, out_size, ws_size); grid = -1; return; }
        int dev = 0, cus = 0, per_cu = 0;
        hipGetDevice(&dev); hipDeviceGetAttribute(&cus, hipDeviceAttributeMultiprocessorCount, dev);
        if (hipFuncSetAttribute((const void*)fwd_kernel, hipFuncAttributeMaxDynamicSharedMemorySize, LDS_BYTES) != hipSuccess) { fprintf(stderr, "kernel_launch: hipFuncSetAttribute failed\n"); grid = -1; return; }
        if (hipOccupancyMaxActiveBlocksPerMultiprocessor(&per_cu, (const void*)fwd_kernel, NWAVES * 64, LDS_BYTES) != hipSuccess || per_cu < 1) { fprintf(stderr, "kernel_launch: occupancy query gave %d\n", per_cu); per_cu = 1; }
        (void)hipGetLastError();
        grid = cus * 1;
        if (grid <= 0) grid = 256;
    }
    if (grid < 0) return;
    if (hipMemsetAsync((char*)d_ws + WS_CTL, 0, CTL_ZERO_BYTES, stream) != hipSuccess) { fprintf(stderr, "kernel_launch: hipMemsetAsync failed\n"); return; }
    Args a{};
    for (int i = 0; i < 13; ++i) a.in[i] = (const float*)d_in[i];
    a.out = (float*)d_out; a.ws = (unsigned char*)d_ws;
#if N_LAUNCH_MODE == 1
    a.ph_lo = 0; a.ph_hi = NPH;
    void* kargs[] = {&a};
    hipError_t e = hipLaunchCooperativeKernel((const void*)fwd_kernel, dim3(grid), dim3(NWAVES * 64), kargs, LDS_BYTES, stream);
    if (e != hipSuccess) fprintf(stderr, "cooperative launch failed: %s (grid %d)\n", hipGetErrorString(e), grid);
#else
    for (int p = 0; p < NPH; ++p) { a.ph_lo = p; a.ph_hi = p + 1; hipLaunchKernelGGL(fwd_kernel, dim3(grid), dim3(NWAVES * 64), LDS_BYTES, stream, a); }
#endif
}
```

```cpp
#include <hip/hip_runtime.h>
#include <hip/hip_cooperative_groups.h>
#include <cstdio>
#include <cstdint>
namespace cg = cooperative_groups;
#ifndef REP_P0
#define REP_P0 1
#endif
#ifndef REP_A
#define REP_A 1
#endif
#ifndef REP_D
#define REP_D 1
#endif
#ifndef REP_B
#define REP_B 1
#endif
#ifndef REP_NA
#define REP_NA 1
#endif
#ifndef REP_DIFF
#define REP_DIFF 1
#endif
#ifndef PROBE_NA
#define PROBE_NA 0
#endif
#ifndef PROBE_DIFF
#define PROBE_DIFF 0
#endif
__device__ __forceinline__ int lane_id_v() { int l; asm volatile("v_mbcnt_lo_u32_b32 %0, -1, 0\n\tv_mbcnt_hi_u32_b32 %0, -1, %0" : "=v"(l)); return l; }
#define N_LAUNCH_MODE 1
namespace pg8 {
#define PG8_LAS __attribute__((address_space(3)))
typedef unsigned short bf16_t;
typedef short bf16x8 __attribute__((ext_vector_type(8)));
typedef float f32x4 __attribute__((ext_vector_type(4)));
typedef unsigned u32x4 __attribute__((ext_vector_type(4)));
constexpr int BM = 256, BK = 64, HALF = 128, HTB = HALF * BK * 2  , STAGE_BYTES = 8 * HTB, NXCD = 8, WGM = 8;

__host__ __device__ __forceinline__ int lds_byte(int r, int c) { const int st = (r >> 4) * 2 + (c >> 5), rr = r & 15, cc = c & 31, ob = rr * 64 + cc * 2; return st * 1024 + (ob ^ (((ob >> 9) & 1) << 5)); }
__host__ __device__ __forceinline__ void stage_rc(int b, int& R, int& C) { const int st = b / 1024, sb = b % 1024, swz = sb ^ (((sb >> 9) & 1) << 5); R = (st >> 1) * 16 + swz / 64; C = (st & 1) * 32 + (swz % 64) / 2; }
__host__ __device__ __forceinline__ int perm32(int rho) { const int n = rho >> 4, i = rho & 15; return 8 * (i >> 2) + 4 * n + (i & 3); }

struct Unit { int pm, pn; };
struct Gemm { const bf16_t* A; const bf16_t* Bt; int M, N, K; };

struct StaticOrder {
    int nM, nN, nwg, G, c;
    __host__ __device__ void init(int M, int N, int G_, int c_) { nM = M / BM; nN = N / BM; nwg = nM * nN; G = G_; c = c_; }
    __host__ __device__ bool next(int i, Unit& u) const {
        const long L = (long)i * G + c; if (L >= nwg) return false;
        int wgid = (int)L; { const int q = nwg / NXCD, r = nwg % NXCD, xcd = wgid % NXCD, off = wgid / NXCD; wgid = (xcd < r ? xcd * (q + 1) : r * (q + 1) + (xcd - r) * q) + off; }
        const int nig = WGM * nN, gid = wgid / nig, fm = gid * WGM, gsz = (nM - fm) < WGM ? (nM - fm) : WGM;
        u.pm = fm + ((wgid % nig) % gsz); u.pn = (wgid % nig) / gsz; return true;
    }
    __device__ __forceinline__ void a_ready(const Unit&) const {}
    __device__ __forceinline__ void done(const Unit&) const {}
};
__device__ __forceinline__ unsigned cvt_pk_bf16(float lo, float hi) { unsigned r; asm volatile("v_cvt_pk_bf16_f32 %0, %1, %2" : "=v"(r) : "v"(lo), "v"(hi)); return r; }
template <class Epi, class Sched, bool ALIGN_EPI = false, bool SP2 = false>
__device__ __forceinline__ void gemm_phase(PG8_LAS unsigned char* lds, const Gemm g, const Sched& S, const Epi& E, const int wid_in) {
    int tid_o = wid_in * 64 + lane_id_v(); asm volatile("" : "+v"(tid_o));
    const int tid = tid_o, wid = __builtin_amdgcn_readfirstlane(tid >> 6), lane = tid & 63, wr = wid >> 2, wc = wid & 3, fr = lane & 15, fq = lane >> 4;
    const int K = g.K, nt = K / BK;
    unsigned voffA[2], voffB[2];
#pragma unroll
    for (int i = 0; i < 2; ++i) { int R, C; stage_rc(tid * 16 + i * 8192, R, C); const int Rb = Epi::PERM ? ((R & ~31) + perm32(R & 31)) : R;
        voffA[i] = (unsigned)(R * K + C) * 2u; voffB[i] = (unsigned)(Rb * K + C) * 2u; }
    const size_t kstep = (size_t)(BK * 2);
    const size_t hstep = (size_t)HALF * K * 2;
    const size_t tstep = 2 * hstep;
    const unsigned ldsw = (unsigned)wid * 1024u;
    const int aoff = lds_byte(wr * 64 + fr, fq * 8), boff = lds_byte(wc * 32 + fr, fq * 8);
#define PG8_SA(b, h) (((b) * 2 + (h)) * HTB)
#define PG8_SB(b, h) ((4 + (b) * 2 + (h)) * HTB)
#define PG8_STAGE(bufoff, gbase, voff) do { _Pragma("unroll") for (int _i = 0; _i < 2; ++_i) \
        __builtin_amdgcn_global_load_lds((const unsigned*)((const char*)(gbase) + (voff)[_i]), (PG8_LAS unsigned*)(lds + (bufoff) + ldsw + _i * 8192), 16, 0, 0); } while (0)
#define PG8_LDA(dst, b, h) do { _Pragma("unroll") for (int m = 0; m < 4; ++m) _Pragma("unroll") for (int k = 0; k < 2; ++k) dst[m][k] = *(const PG8_LAS bf16x8*)(lds + PG8_SA(b, h) + aoff + m * 2048 + k * 1024); } while (0)
#define PG8_LDB(dst, b, h) do { _Pragma("unroll") for (int n = 0; n < 2; ++n) _Pragma("unroll") for (int k = 0; k < 2; ++k) dst[n][k] = *(const PG8_LAS bf16x8*)(lds + PG8_SB(b, h) + boff + n * 2048 + k * 1024); } while (0)
#define PG8_MMA(ai, bj, At, Bt) do { __builtin_amdgcn_s_setprio(1); _Pragma("unroll") for (int m = 0; m < 4; ++m) _Pragma("unroll") for (int n = 0; n < 2; ++n) _Pragma("unroll") for (int k = 0; k < 2; ++k) \
        acc[ai][bj][m][n] = __builtin_amdgcn_mfma_f32_16x16x32_bf16(Bt[n][k], At[m][k], acc[ai][bj][m][n], 0, 0, 0); __builtin_amdgcn_s_setprio(0); } while (0)
#define PG8_WAIT_V(n) asm volatile("s_waitcnt vmcnt(" #n ")" ::: "memory")
#define PG8_WAIT_L(n) asm volatile("s_waitcnt lgkmcnt(" #n ")" ::: "memory")
#define PG8_BAR __builtin_amdgcn_s_barrier()
#define PG8_SCHED __builtin_amdgcn_sched_barrier(0)
    Unit cur, nxt; int ui = 0;
    if (!S.next(0, cur)) return;
    f32x4 acc[2][2][4][2];
#pragma unroll
    for (int a = 0; a < 2; ++a)
#pragma unroll
        for (int b = 0; b < 2; ++b)
#pragma unroll
            for (int m = 0; m < 4; ++m)
#pragma unroll
                for (int n = 0; n < 2; ++n) acc[a][b][m][n] = (f32x4){0.f, 0.f, 0.f, 0.f};
    bf16x8 At[4][2], B0[2][2], B1[2][2];
    const char* cA = (const char*)g.A + (size_t)cur.pm * tstep; const char* cB = (const char*)g.Bt + (size_t)cur.pn * tstep;
    S.a_ready(cur);
    if constexpr (SP2) {
        PG8_STAGE(PG8_SB(0, 0), cB, voffB); PG8_STAGE(PG8_SB(0, 1), cB + hstep, voffB); PG8_STAGE(PG8_SA(0, 0), cA, voffA); PG8_STAGE(PG8_SA(0, 1), cA + hstep, voffA);
        if (wr == 1) PG8_BAR;
        PG8_WAIT_V(2); PG8_BAR;
        PG8_STAGE(PG8_SB(1, 0), cB + kstep, voffB); PG8_STAGE(PG8_SA(1, 0), cA + kstep, voffA); PG8_STAGE(PG8_SB(1, 1), cB + hstep + kstep, voffB);
        PG8_WAIT_V(6); PG8_BAR;
    } else {
        PG8_STAGE(PG8_SB(0, 0), cB, voffB); PG8_STAGE(PG8_SA(0, 0), cA, voffA); PG8_STAGE(PG8_SB(0, 1), cB + hstep, voffB); PG8_STAGE(PG8_SA(0, 1), cA + hstep, voffA);
        if (wr == 1) PG8_BAR;
        PG8_WAIT_V(4); PG8_BAR;
        PG8_STAGE(PG8_SB(1, 0), cB + kstep, voffB); PG8_STAGE(PG8_SA(1, 0), cA + kstep, voffA); PG8_STAGE(PG8_SB(1, 1), cB + hstep + kstep, voffB);
        PG8_WAIT_V(6); PG8_BAR;
    }
    for (;;) {
        const bool has_next = S.next(ui + 1, nxt);
        const char* nA = has_next ? (const char*)g.A + (size_t)nxt.pm * tstep : cA; const char* nB = has_next ? (const char*)g.Bt + (size_t)nxt.pn * tstep : cB;
        for (int t = 0; t < nt; t += 2) {
            const bool last = (t == nt - 2);
            const char* a1 = cA + (size_t)(t + 1) * kstep;
            const char* a2 = last ? nA : cA + (size_t)(t + 2) * kstep; const char* b2 = last ? nB : cB + (size_t)(t + 2) * kstep;
            const char* a3 = a2 + kstep; const char* b3 = b2 + kstep;
            if (last && has_next) S.a_ready(nxt);
            if constexpr (SP2) {
            PG8_LDB(B0, 0, 0); PG8_LDB(B1, 0, 1); PG8_SCHED; PG8_LDA(At, 0, 0); PG8_STAGE(PG8_SA(1, 1), a1 + hstep, voffA);
            PG8_WAIT_V(8); PG8_WAIT_L(0); PG8_BAR; PG8_MMA(0, 0, At, B0); PG8_MMA(0, 1, At, B1); PG8_BAR; PG8_SCHED;
            PG8_LDA(At, 0, 1); PG8_STAGE(PG8_SB(0, 0), b2, voffB); PG8_STAGE(PG8_SB(0, 1), b2 + hstep, voffB); PG8_STAGE(PG8_SA(0, 0), a2, voffA);
            PG8_WAIT_V(8); PG8_WAIT_L(0); PG8_BAR; PG8_MMA(1, 0, At, B0); PG8_MMA(1, 1, At, B1); PG8_BAR; PG8_SCHED;
            PG8_LDB(B0, 1, 0); PG8_LDB(B1, 1, 1); PG8_SCHED; PG8_LDA(At, 1, 0); PG8_STAGE(PG8_SA(0, 1), a2 + hstep, voffA);
            PG8_WAIT_V(8); PG8_WAIT_L(0); PG8_BAR; PG8_MMA(0, 0, At, B0); PG8_MMA(0, 1, At, B1); PG8_BAR; PG8_SCHED;
            PG8_LDA(At, 1, 1); PG8_STAGE(PG8_SB(1, 0), b3, voffB); PG8_STAGE(PG8_SB(1, 1), b3 + hstep, voffB); PG8_STAGE(PG8_SA(1, 0), a3, voffA);
            PG8_WAIT_V(8); PG8_WAIT_L(0); PG8_BAR; PG8_MMA(1, 0, At, B0); PG8_MMA(1, 1, At, B1); PG8_BAR; PG8_SCHED;
            } else {
            PG8_LDB(B0, 0, 0); PG8_SCHED; PG8_LDA(At, 0, 0); PG8_STAGE(PG8_SA(1, 1), a1 + hstep, voffA);
            PG8_WAIT_L(8); PG8_BAR; PG8_WAIT_L(0); PG8_MMA(0, 0, At, B0); PG8_BAR; PG8_SCHED;
            PG8_LDB(B1, 0, 1); PG8_STAGE(PG8_SB(0, 0), b2, voffB);
            PG8_BAR; PG8_WAIT_L(0); PG8_MMA(0, 1, At, B1); PG8_BAR;
            PG8_LDA(At, 0, 1); PG8_STAGE(PG8_SA(0, 0), a2, voffA);
            PG8_BAR; PG8_WAIT_L(0); PG8_MMA(1, 0, At, B0); PG8_BAR; PG8_SCHED;
            PG8_STAGE(PG8_SB(0, 1), b2 + hstep, voffB);
            PG8_WAIT_V(6); PG8_BAR; PG8_MMA(1, 1, At, B1); PG8_BAR;
            PG8_LDB(B0, 1, 0); PG8_SCHED; PG8_LDA(At, 1, 0); PG8_STAGE(PG8_SA(0, 1), a2 + hstep, voffA);
            PG8_WAIT_L(8); PG8_BAR; PG8_WAIT_L(0); PG8_MMA(0, 0, At, B0); PG8_BAR; PG8_SCHED;
            PG8_LDB(B1, 1, 1); PG8_STAGE(PG8_SB(1, 0), b3, voffB);
            PG8_BAR; PG8_WAIT_L(0); PG8_MMA(0, 1, At, B1); PG8_BAR;
            PG8_LDA(At, 1, 1); PG8_STAGE(PG8_SA(1, 0), a3, voffA);
            PG8_BAR; PG8_WAIT_L(0); PG8_MMA(1, 0, At, B0); PG8_BAR; PG8_SCHED;
            PG8_STAGE(PG8_SB(1, 1), b3 + hstep, voffB);
            PG8_WAIT_V(6); PG8_BAR; PG8_MMA(1, 1, At, B1); PG8_BAR;
            }
        }
        if constexpr (ALIGN_EPI) { if (wr == 0) PG8_BAR; }
        if constexpr (!Epi::AFTER_DRAIN) { E(acc, cur, wr, wc, fr, fq); S.done(cur); }
        if (!has_next) break;
#pragma unroll
        for (int a = 0; a < 2; ++a)
#pragma unroll
            for (int b = 0; b < 2; ++b)
#pragma unroll
                for (int m = 0; m < 4; ++m)
#pragma unroll
                    for (int n = 0; n < 2; ++n) acc[a][b][m][n] = (f32x4){0.f, 0.f, 0.f, 0.f};
        cur = nxt; cA = nA; cB = nB; ++ui;
        if constexpr (ALIGN_EPI) { if (wr == 1) PG8_BAR; }
    }
    PG8_WAIT_V(0);
    if constexpr (!ALIGN_EPI) { if (wr == 0) PG8_BAR; }
    PG8_BAR;
    if constexpr (Epi::AFTER_DRAIN) { E.fused(acc, cur, wr, wc, fr, fq, lds, wid, lane); S.done(cur); }
#undef PG8_SA
#undef PG8_SB
#undef PG8_STAGE
#undef PG8_LDA
#undef PG8_LDB
#undef PG8_MMA
#undef PG8_WAIT_V
#undef PG8_WAIT_L
#undef PG8_BAR
#undef PG8_SCHED
}
}

#define GAS __attribute__((address_space(1)))
#define LAS __attribute__((address_space(3)))
typedef unsigned short bf16;
typedef unsigned v4u __attribute__((ext_vector_type(4)));
typedef unsigned v2u __attribute__((ext_vector_type(2)));
typedef float f32x4 __attribute__((ext_vector_type(4)));
typedef float f32x16 __attribute__((ext_vector_type(16)));
typedef short bf16x8 __attribute__((ext_vector_type(8)));
typedef short s16x4 __attribute__((ext_vector_type(4)));
typedef GAS unsigned gu32;
#define RLX_AGENT __ATOMIC_RELAXED, __HIP_MEMORY_SCOPE_AGENT
#define LDS_WAIT() asm volatile("s_waitcnt lgkmcnt(0)" ::: "memory")
#define VM_WAIT() asm volatile("s_waitcnt vmcnt(0)" ::: "memory")

constexpr int DM = 1024, NB = 8, SEQ = 4096, CTXL = 256, DEPTH = 4;
constexpr int MX = NB * SEQ, MC = NB * CTXL, MT = MX + MC;
constexpr float ALPHA = 1.681792830507429f;
constexpr float LN_EPS = 1e-5f;
constexpr float LOG2E = 1.4426950408889634f;
constexpr float QSCALE = 0.125f * LOG2E;
constexpr int NWAVES = 8;
constexpr int NPH = 2 + 4 * DEPTH;

constexpr size_t MiB = 1u << 20;
constexpr size_t WS_CTL = 0, CTL_ZERO_BYTES = 64 * 1024;
constexpr int CW_BAR = 1024, CW_SUB = 8192;
constexpr size_t WS_MOD = 1 * MiB;
constexpr size_t WS_COS = 1 * MiB + 512 * 1024, WS_SIN = WS_COS + 4096;
constexpr size_t WS_STATS = 1 * MiB + 640 * 1024;
constexpr size_t WS_WIN = 2 * MiB;
constexpr size_t WS_WOUT = 34 * MiB;
constexpr size_t WS_XRC = 42 * MiB;
constexpr size_t WS_XN = 50 * MiB;
constexpr size_t ACT = (size_t)68 * MiB;
constexpr size_t WS_Q = 118 * MiB, WS_K = WS_Q + ACT, WS_V = WS_K + ACT, WS_Z = WS_V + ACT, WS_YZ = WS_Z + ACT, WS_END = WS_YZ + ACT;
constexpr int NAB_TINT = 65536, NAB_TB = NAB_TINT + 16 * 512, NAB_RPB = NAB_TB + 15 * 16 * 256 + 512;
constexpr int LDS_BYTES = 147456;

__device__ __forceinline__ unsigned f2bf(float f) { unsigned u = __builtin_bit_cast(unsigned, f); return (u + 0x7fffu + ((u >> 16) & 1u)) >> 16; }
__device__ __forceinline__ unsigned pk2(float lo, float hi) { return f2bf(lo) | (f2bf(hi) << 16); }
typedef float f32x2_t __attribute__((ext_vector_type(2))); typedef __bf16 bf16x2_t __attribute__((ext_vector_type(2)));
__device__ __forceinline__ unsigned cvtpk(float lo, float hi) { f32x2_t v = {lo, hi}; bf16x2_t b = __builtin_convertvector(v, bf16x2_t); return __builtin_bit_cast(unsigned, b); }
__device__ __forceinline__ float bflo(unsigned u) { return __builtin_bit_cast(float, u << 16); }
__device__ __forceinline__ float bfhi(unsigned u) { return __builtin_bit_cast(float, u & 0xffff0000u); }
__device__ __forceinline__ float wave_sum(float v) {
#pragma unroll
    for (int o = 1; o < 64; o <<= 1) v += __shfl_xor(v, o);
    return v;
}
__device__ __forceinline__ float silu_f(float v) { return v * __builtin_amdgcn_rcpf(1.f + __builtin_amdgcn_exp2f(-1.4426950408889634f * v)); }

namespace pg8 {
struct EpiIn {
    static constexpr bool PERM = true, AFTER_DRAIN = false;
    bf16_t* Q; size_t stride; int rope; const float* cosT; const float* sinT;
    __device__ __forceinline__ void operator()(const f32x4 (&acc)[2][2][4][2], const Unit& u, int wr, int wc, int fr, int fq) const {
        const int t = u.pn >> 2, colt = (u.pn & 3) * 256;
        bf16_t* base = Q + (size_t)t * stride;
        const int row0 = u.pm * BM + wr * 64 + fr, col0 = colt + wc * 32 + 8 * fq;
        const bool do_rope = rope && t < 2 && u.pm < (MX / BM);
        const int half = wc & 1, f0 = 8 * (fq & 1);
        const float sgn = (fq >> 1) ? 1.f : -1.f;
#pragma unroll
        for (int ai = 0; ai < 2; ++ai)
#pragma unroll
            for (int m = 0; m < 4; ++m) {
                const int row = row0 + ai * HALF + m * 16;
                bf16_t* rowp = (t == 3) ? base + (size_t)row * 1024 + col0 : base + ((size_t)(col0 >> 6) * MT + row) * 64 + (col0 & 63);
                f32x4 c0 = {1.f, 1.f, 1.f, 1.f}, c1 = c0, s0 = {0.f, 0.f, 0.f, 0.f}, s1 = s0;
                if (do_rope) { const int tok = row & (SEQ - 1); const int pos = half ? (tok & 63) : (tok >> 6);
                    c0 = *(const f32x4*)(cosT + pos * 16 + f0); c1 = *(const f32x4*)(cosT + pos * 16 + f0 + 4);
                    s0 = *(const f32x4*)(sinT + pos * 16 + f0) * sgn; s1 = *(const f32x4*)(sinT + pos * 16 + f0 + 4) * sgn; }
#pragma unroll
                for (int bj = 0; bj < 2; ++bj) {
                    f32x4 v0 = acc[ai][bj][m][0], v1 = acc[ai][bj][m][1];
                    if (t == 3) {
#pragma unroll
                        for (int j = 0; j < 4; ++j) { v0[j] = silu_f(v0[j]); v1[j] = silu_f(v1[j]); }
                    } else if (do_rope) {
                        f32x4 p0, p1;
#pragma unroll
                        for (int j = 0; j < 4; ++j) { p0[j] = __shfl_xor(v0[j], 32); p1[j] = __shfl_xor(v1[j], 32); }
                        v0 = v0 * c0 + p0 * s0; v1 = v1 * c1 + p1 * s1;
                    }
                    if (t == 0) { v0 = v0 * QSCALE; v1 = v1 * QSCALE; }
                    u32x4 w; w.x = cvt_pk_bf16(v0[0], v0[1]); w.y = cvt_pk_bf16(v0[2], v0[3]); w.z = cvt_pk_bf16(v1[0], v1[1]); w.w = cvt_pk_bf16(v1[2], v1[3]);
                    *(u32x4*)(rowp + (t == 3 ? bj * HALF : bj * 2 * MT * 64)) = w;
                }
            }
    }
};
struct EpiOut {
    static constexpr bool PERM = false, AFTER_DRAIN = false;
    const float* res_x; const float* res_c; float* out_x; float* out_c; const float* modl;
    const float* stats; const float* lng; const float* lnb;
    __device__ __forceinline__ void operator()(const f32x4 (&acc)[2][2][4][2], const Unit& u, int wr, int wc, int fr, int fq) const {
        const bool isc = u.pm >= (MX / BM);
        const int rbase = (isc ? u.pm - MX / BM : u.pm) * BM + wr * 64 + fr;
        const float* res = isc ? res_c : res_x; float* out = isc ? out_c : out_x;
        const int bidx = isc ? 8 : (u.pm >> 4);
        const int col0 = u.pn * BM + wc * 32 + 4 * fq;
        const float* g = modl + bidx * 3072 + 2048 + col0;
        f32x4 gv[2][2], lg[2][2], lb[2][2];
#pragma unroll
        for (int bj = 0; bj < 2; ++bj)
#pragma unroll
            for (int n = 0; n < 2; ++n) { gv[bj][n] = *(const f32x4*)(g + bj * HALF + n * 16) + 1.f;
                if (stats) { lg[bj][n] = *(const f32x4*)(lng + col0 + bj * HALF + n * 16) * ALPHA; lb[bj][n] = *(const f32x4*)(lnb + col0 + bj * HALF + n * 16) * ALPHA; }
                else { lg[bj][n] = (f32x4){ALPHA, ALPHA, ALPHA, ALPHA}; lb[bj][n] = (f32x4){0.f, 0.f, 0.f, 0.f}; } }
        const int srow0 = (isc ? MX : 0) + rbase;
#pragma unroll
        for (int ai = 0; ai < 2; ++ai)
#pragma unroll
            for (int m = 0; m < 4; ++m) { const int rr = rbase + ai * HALF + m * 16; const size_t off = (size_t)rr * 1024 + col0;
                float mean = 0.f, rstd = 1.f;
                if (stats) { const float* sp = stats + 2 * (size_t)(srow0 + ai * HALF + m * 16); mean = sp[0]; rstd = sp[1]; }
#pragma unroll
                for (int bj = 0; bj < 2; ++bj)
#pragma unroll
                    for (int n = 0; n < 2; ++n) { const f32x4 r4 = *(const f32x4*)(res + off + bj * HALF + n * 16);
                        *(f32x4*)(out + off + bj * HALF + n * 16) = ((r4 - mean) * rstd) * lg[bj][n] + lb[bj][n] + gv[bj][n] * acc[ai][bj][m][n]; }
                if (m & 1) asm volatile("" ::: "memory"); }
    }
};
}

#define MFMA32(a, b, c) __builtin_amdgcn_mfma_f32_32x32x16_bf16((a), (b), (c), 0, 0, 0)
typedef short v4i16_t __attribute__((ext_vector_type(4)));
__device__ __forceinline__ s16x4 vtr(const LAS unsigned char* p) { return __builtin_bit_cast(s16x4, __builtin_amdgcn_ds_read_tr16_b64_v4i16((LAS v4i16_t*)p)); }
__device__ __forceinline__ int crow(int r, int hi) { return (r & 3) + 8 * (r >> 2) + 4 * hi; }
__device__ __forceinline__ int clampi(int v, int lo, int hi) { return v < lo ? lo : (v > hi ? hi : v); }

__device__ __forceinline__ float max3f(float a, float b, float c) { float r; asm("v_max3_f32 %0, %1, %2, %3" : "=v"(r) : "v"(a), "v"(b), "v"(c)); return r; }
__device__ __forceinline__ void glds16(const void* gbase, unsigned voff_bytes, unsigned lds_dst) { unsigned keep;
    asm volatile("s_mov_b32 %0, m0\n\ts_mov_b32 m0, %3\n\ts_nop 0\n\tglobal_load_lds_dwordx4 %1, %2\n\ts_mov_b32 m0, %0" : "=&s"(keep) : "v"(voff_bytes), "s"(gbase), "s"(lds_dst) : "memory"); }
#define ATT_WAITBAR(N) asm volatile("s_waitcnt vmcnt(" #N ") lgkmcnt(0)\n\ts_barrier" ::: "memory")
template <int DVB, bool NA, bool SPLIT>
__device__ __forceinline__ void attn_unit(const int PROBE, const int wid_in, LAS unsigned char* lds, const bf16* Q, const bf16* Km, const bf16* Vm, const bf16* SZ, bf16* YZ,
                                          int q_row0, int qcol, int vcol, int seg1, int n1, int seg2, int n2, int kr0, bool xunit, int rq0,
                                          const LAS float* rpbL, float lam, float omli, const float* subg) {
    constexpr int KMAPS = SPLIT ? 2 : 1, KB = 8192, STAGE = KMAPS * KB + DVB * 4096, NS = 4, IPT = KMAPS + DVB / 2;
    static_assert(IPT == 2 || IPT == 4, "DMA instructions per tile per thread");
    int tid_o = wid_in * 64 + lane_id_v(); asm volatile("" : "+v"(tid_o));
    const int tid = tid_o, lane = tid & 63, wid = wid_in, r32 = lane & 31, hi = lane >> 5;
    const int NT = n1 + n2;
    const int wq_off = SPLIT ? (wid & 3) * 32 : wid * 32, wmap = SPLIT ? (wid >> 2) : 0;
    const unsigned lds0 = (unsigned)(uintptr_t)lds;
    const unsigned koff = (unsigned)((wid * 8 + (lane >> 3)) * 64 + (((lane & 7) ^ ((4 * (wid & 1) + (lane >> 4)) & 7)) * 8));
    unsigned voff[DVB / 2];
#pragma unroll
    for (int i = 0; i < DVB / 2; ++i) { const int p = wid + 8 * i, dvb = p >> 2, g8 = 2 * (p & 3) + (lane >> 5), row = g8 * 8 + ((lane & 31) >> 2);
        voff[i] = (unsigned)(((size_t)0 + (dvb >> 1)) * MT * 64 + row * 64 + (dvb & 1) * 32 + (lane & 3) * 8); }
#define ATT_ISSUE(t, slot) do { if (PROBE == 1) break; const int rb_ = (t) < n1 ? seg1 + 64 * (t) : seg2 + 64 * ((t) - n1); const unsigned sb_ = lds0 + (slot) * STAGE + wid * 1024; \
        _Pragma("unroll") for (int m_ = 0; m_ < KMAPS; ++m_) glds16(Km + ((size_t)((qcol >> 6) + m_) * MT + rb_) * 64, koff * 2u, (unsigned)__builtin_amdgcn_readfirstlane(sb_ + m_ * KB)); \
        _Pragma("unroll") for (int i_ = 0; i_ < DVB / 2; ++i_) glds16(Vm + ((size_t)(vcol >> 6) * MT + rb_) * 64, voff[i_] * 2u, (unsigned)__builtin_amdgcn_readfirstlane(sb_ + KMAPS * KB + i_ * 8192)); } while (0)
#pragma unroll
    for (int t = 0; t < 2; ++t) if (t < NT) ATT_ISSUE(t, t);
    bf16x8 qf[4];
#define ATT_QROW(j) ((NA && xunit) ? (q_row0 + ((wid >> 2) * 2 + ((j) >> 4)) * 64 + (wid & 3) * 16 + ((j) & 15)) : (q_row0 + wq_off + (j)))
    { const bf16* qp = Q + ((size_t)((qcol >> 6) + wmap) * MT + ATT_QROW(r32)) * 64 + hi * 8;
#pragma unroll
      for (int d0 = 0; d0 < 4; ++d0) qf[d0] = *(const bf16x8*)(qp + d0 * 16); }
    asm volatile("" : "+v"(qf[0]), "+v"(qf[1]), "+v"(qf[2]), "+v"(qf[3]));
    float mrun = 0.f; f32x16 o[DVB], ol, negm;
    bool seen = false;
    bool pend = false;
#pragma unroll
    for (int d = 0; d < DVB; ++d)
#pragma unroll
        for (int r = 0; r < 16; ++r) o[d][r] = 0.f;
#pragma unroll
    for (int r = 0; r < 16; ++r) { ol[r] = 0.f; negm[r] = 0.f; }
    const bf16x8 ones = {0x3f80, 0x3f80, 0x3f80, 0x3f80, 0x3f80, 0x3f80, 0x3f80, 0x3f80};
    const int rowA = rq0 + 2 * (wid >> 2), row_l = rowA + (r32 >> 4), r0_l = clampi(row_l - 4, 0, 56);
    const int r0A = clampi(rowA - 4, 0, 56), r0B = clampi(rowA - 3, 0, 56);
    const int wq = 16 * (wid & 3) + (r32 & 15);
    const int cbk = (wid & 3) == 0 ? 0 : ((wid & 3) == 1 ? 8 : ((wid & 3) == 2 ? 24 : 32));
    const bool nab_int = (wq >= 8 && wq <= 56);
    const int nab_v = wq < 8 ? wq : wq - 49;
    const int nab_base = nab_int ? (NAB_TINT + (cbk + 4 * hi - wq + 63) * 4) : (NAB_TB + nab_v * (16 * 256) + (cbk + 4 * hi) * 4);
    const int nab_stride = nab_int ? 512 : 256;
    const int kbyteW = (cbk + r32) * 128, kxW = ((cbk + r32) >> 1) & 7;
    const int kbyte = r32 * 128, kx = (r32 >> 1) & 7;
    const int vlane = (4 * hi + ((lane & 15) >> 2)) * 64 + ((lane >> 4) & 1) * 32 + (lane & 3) * 8;
    constexpr int DH = DVB / 2;
    const f32x16 zero16 = {0.f, 0.f, 0.f, 0.f, 0.f, 0.f, 0.f, 0.f, 0.f, 0.f, 0.f, 0.f, 0.f, 0.f, 0.f, 0.f};
    v4u pw[4];
#pragma unroll
    for (int j = 0; j < 4; ++j) pw[j] = (v4u){0u, 0u, 0u, 0u};
#define ATT_VREAD(vfa, dlo, dhi, vbp) do { _Pragma("unroll") for (int d_ = (dlo); d_ < (dhi); ++d_) _Pragma("unroll") for (int ks_ = 0; ks_ < 4; ++ks_) { \
        const s16x4 lo_ = vtr((vbp) + (d_ * 8 + 2 * ks_) * 512), h4_ = vtr((vbp) + (d_ * 8 + 2 * ks_ + 1) * 512); \
        vfa[d_][ks_] = (bf16x8){lo_[0], lo_[1], lo_[2], lo_[3], h4_[0], h4_[1], h4_[2], h4_[3]}; } } while (0)
#define ATT_PV2(vfa, dlo, dhi) do { _Pragma("unroll") for (int d_ = (dlo); d_ < (dhi); ++d_) _Pragma("unroll") for (int ks_ = 0; ks_ < 4; ++ks_) o[d_] = MFMA32(vfa[d_][ks_], __builtin_bit_cast(bf16x8, pw[ks_]), o[d_]); } while (0)
#define ATT_SB() __builtin_amdgcn_sched_barrier(0)
    for (int t = 0; t < NT; ++t) {
        if (NA) {
            if ((t & 1) == 0) { ATT_WAITBAR(0);
                if (t + 2 < NT) ATT_ISSUE(t + 2, (t + 2) & (NS - 1));
                if (t + 3 < NT) ATT_ISSUE(t + 3, (t + 3) & (NS - 1)); }
        } else {
        { const int rem = NT - 1 - t;
          if (IPT == 4) { if (rem >= 1) ATT_WAITBAR(4); else ATT_WAITBAR(0); }
          else          { if (rem >= 1) ATT_WAITBAR(2); else ATT_WAITBAR(0); } }
        if (t + 2 < NT) ATT_ISSUE(t + 2, (t + 2) & (NS - 1));
        }
        const bool win = NA && xunit && t < n1;
        const int kr = kr0 + t;
        const bool active = (PROBE != 2) && (!win || (kr >= r0A && kr <= r0B + 7));
        if (NA && win && active) {
            const LAS unsigned char* sb = lds + (t & (NS - 1)) * STAGE;
            const LAS unsigned char* vbw = sb + KMAPS * KB + vlane + (cbk >> 3) * 512;
            const int trow = (kr >= r0_l && kr <= r0_l + 7) ? kr - row_l + 8 : 0;
            const LAS unsigned char* tb = lds + nab_base + trow * nab_stride;
            f32x16 cbv; bf16x8 kaw[4], vfw[DVB][2];
#pragma unroll
            for (int r = 0; r < 16; ++r) cbv[r] = *(const LAS float*)(tb + 4 * ((r & 3) + 8 * (r >> 2)));
#pragma unroll
            for (int d0 = 0; d0 < 4; ++d0) kaw[d0] = *(const LAS bf16x8*)(sb + kbyteW + (((2 * d0 + hi) ^ kxW) * 16));
            ATT_SB();
#pragma unroll
            for (int d = 0; d < DVB; ++d)
#pragma unroll
                for (int ks = 0; ks < 2; ++ks) { const s16x4 lo_ = vtr(vbw + (d * 8 + 2 * ks) * 512), h4_ = vtr(vbw + (d * 8 + 2 * ks + 1) * 512);
                    vfw[d][ks] = (bf16x8){lo_[0], lo_[1], lo_[2], lo_[3], h4_[0], h4_[1], h4_[2], h4_[3]}; }
            ATT_SB();
            __builtin_amdgcn_s_setprio(1);
            f32x16 s0 = MFMA32(kaw[0], qf[0], cbv);
#pragma unroll
            for (int d0 = 1; d0 < 4; ++d0) s0 = MFMA32(kaw[d0], qf[d0], s0);
            __builtin_amdgcn_s_setprio(0);
            ATT_SB();
#pragma unroll
            for (int r = 0; r < 16; ++r) s0[r] -= mrun;
            float mx;
            { const float t0 = max3f(s0[0], s0[1], s0[2]), t1 = max3f(s0[3], s0[4], s0[5]), t2 = max3f(s0[6], s0[7], s0[8]), t3 = max3f(s0[9], s0[10], s0[11]), t4 = max3f(s0[12], s0[13], s0[14]);
              mx = max3f(max3f(t0, t1, t2), max3f(t3, t4, s0[15]), -3e38f); }
            mx = fmaxf(mx, __shfl_xor(mx, 32));
            const bool live = mx > -1e29f;
            if (__builtin_amdgcn_ballot_w64((live && !seen) || mx > 8.f) != 0ull) {
                const float dl = seen ? fmaxf(mx, 0.f) : (live ? mx : 0.f), al = seen ? __builtin_amdgcn_exp2f(-dl) : 0.f;
                mrun += dl; seen = seen || live;
#pragma unroll
                for (int r = 0; r < 16; ++r) { s0[r] -= dl; negm[r] = -mrun; ol[r] *= al; }
#pragma unroll
                for (int d = 0; d < DVB; ++d)
#pragma unroll
                    for (int r = 0; r < 16; ++r) o[d][r] *= al;
            }
#pragma unroll
            for (int r = 0; r < 16; ++r) s0[r] = __builtin_amdgcn_exp2f(s0[r]);
#pragma unroll
            for (int j = 0; j < 4; ++j) { pw[0][j] = cvtpk(s0[2 * j], s0[2 * j + 1]); pw[1][j] = cvtpk(s0[8 + 2 * j], s0[8 + 2 * j + 1]); }
            ATT_SB();
            __builtin_amdgcn_s_setprio(1);
#pragma unroll
            for (int d = 0; d < DVB; ++d)
#pragma unroll
                for (int ks = 0; ks < 2; ++ks) o[d] = MFMA32(vfw[d][ks], __builtin_bit_cast(bf16x8, pw[ks]), o[d]);
#pragma unroll
            for (int ks = 0; ks < 2; ++ks) ol = MFMA32(ones, __builtin_bit_cast(bf16x8, pw[ks]), ol);
            __builtin_amdgcn_s_setprio(0);
        } else if (!NA && active) {
            const LAS unsigned char* sb = lds + (t & (NS - 1)) * STAGE;
            const LAS unsigned char* kb_ = sb + wmap * KB + kbyte;
            const LAS unsigned char* vbp = lds + ((t ? t - 1 : 0) & (NS - 1)) * STAGE + KMAPS * KB + vlane;
            bf16x8 ka[4], kc[4], vf[DVB][4];
#pragma unroll
            for (int d0 = 0; d0 < 4; ++d0) { const int ch = ((2 * d0 + hi) ^ kx) * 16;
                ka[d0] = *(const LAS bf16x8*)(kb_ + ch); kc[d0] = *(const LAS bf16x8*)(kb_ + 4096 + ch); }
            ATT_SB();
            ATT_VREAD(vf, 0, DH, vbp);
            ATT_SB();
            __builtin_amdgcn_s_setprio(1);
            f32x16 s0 = MFMA32(ka[0], qf[0], zero16), s1 = MFMA32(kc[0], qf[0], zero16);
#pragma unroll
            for (int d0 = 1; d0 < 4; ++d0) { s0 = MFMA32(ka[d0], qf[d0], s0); s1 = MFMA32(kc[d0], qf[d0], s1); }
            __builtin_amdgcn_s_setprio(0);
            ATT_SB();
            float mx;
            { float t0 = max3f(s0[0], s0[1], s0[2]), t1 = max3f(s0[3], s0[4], s0[5]), t2 = max3f(s0[6], s0[7], s0[8]), t3 = max3f(s0[9], s0[10], s0[11]), t4 = max3f(s0[12], s0[13], s0[14]);
              float u0 = max3f(s1[0], s1[1], s1[2]), u1 = max3f(s1[3], s1[4], s1[5]), u2 = max3f(s1[6], s1[7], s1[8]), u3 = max3f(s1[9], s1[10], s1[11]), u4 = max3f(s1[12], s1[13], s1[14]);
              t0 = max3f(t0, t1, t2); t3 = max3f(t3, t4, s0[15]); u0 = max3f(u0, u1, u2); u3 = max3f(u3, u4, s1[15]);
              mx = fmaxf(max3f(t0, t3, u0), u3); }
            mx = fmaxf(mx, __shfl_xor(mx, 32));
            if (__builtin_amdgcn_ballot_w64(!seen || mx > mrun + 8.f) != 0ull) {
                { bf16x8 vfz[DVB][4]; ATT_VREAD(vfz, 0, DVB, vbp); ATT_PV2(vfz, 0, DVB);
#pragma unroll
                    for (int ks = 0; ks < 4; ++ks) ol = MFMA32(ones, __builtin_bit_cast(bf16x8, pw[ks]), ol);
#pragma unroll
                    for (int j = 0; j < 4; ++j) pw[j] = (v4u){0u, 0u, 0u, 0u}; }
                const float mn = seen ? fmaxf(mrun, mx) : mx, al = seen ? __builtin_amdgcn_exp2f(mrun - mn) : 0.f;
                mrun = mn; seen = true;
#pragma unroll
                for (int r = 0; r < 16; ++r) ol[r] *= al;
#pragma unroll
                for (int d = 0; d < DVB; ++d)
#pragma unroll
                    for (int r = 0; r < 16; ++r) o[d][r] *= al;
            }
            ATT_SB();
            v4u pwn[4];
            {
                ATT_VREAD(vf, DH, DVB, vbp);
                ATT_PV2(vf, 0, DH);
#pragma unroll
                for (int ks = 0; ks < 4; ++ks) ol = MFMA32(ones, __builtin_bit_cast(bf16x8, pw[ks]), ol);
                ATT_PV2(vf, DH, DVB);
#pragma unroll
                for (int r = 0; r < 16; ++r) { s0[r] = __builtin_amdgcn_exp2f(s0[r] - mrun); s1[r] = __builtin_amdgcn_exp2f(s1[r] - mrun); }
#pragma unroll
                for (int j = 0; j < 4; ++j) { pwn[0][j] = cvtpk(s0[2 * j], s0[2 * j + 1]); pwn[1][j] = cvtpk(s0[8 + 2 * j], s0[8 + 2 * j + 1]);
                                              pwn[2][j] = cvtpk(s1[2 * j], s1[2 * j + 1]); pwn[3][j] = cvtpk(s1[8 + 2 * j], s1[8 + 2 * j + 1]); }
#pragma unroll
                for (int g = 0; g < 8; ++g) { __builtin_amdgcn_sched_group_barrier(0x008, 1, 0); __builtin_amdgcn_sched_group_barrier(0x100, 2, 0); __builtin_amdgcn_sched_group_barrier(0x002, 1, 0); __builtin_amdgcn_sched_group_barrier(0x400, 1, 0); }
#pragma unroll
                for (int g = 0; g < 12; ++g) { __builtin_amdgcn_sched_group_barrier(0x008, 1, 0); __builtin_amdgcn_sched_group_barrier(0x002, 3, 0); __builtin_amdgcn_sched_group_barrier(0x400, 2, 0); }
            }
            ATT_SB();
#pragma unroll
            for (int j = 0; j < 4; ++j) pw[j] = pwn[j];
            pend = true;
        } else if (active) {
            const LAS unsigned char* sb = lds + (t & (NS - 1)) * STAGE;
            const LAS unsigned char* kb_ = sb + wmap * KB + kbyte;
            const LAS unsigned char* vb_ = sb + KMAPS * KB + vlane;
            bf16x8 ka[4], kc[4], vf[DVB][4];
#pragma unroll
            for (int d0 = 0; d0 < 4; ++d0) { const int ch = ((2 * d0 + hi) ^ kx) * 16;
                ka[d0] = *(const LAS bf16x8*)(kb_ + ch); kc[d0] = *(const LAS bf16x8*)(kb_ + 4096 + ch); }
            ATT_SB();
            ATT_VREAD(vf, 0, DH, vb_);
            ATT_SB();
            __builtin_amdgcn_s_setprio(1);
            f32x16 s0 = MFMA32(ka[0], qf[0], negm), s1 = MFMA32(kc[0], qf[0], negm);
#pragma unroll
            for (int d0 = 1; d0 < 4; ++d0) { s0 = MFMA32(ka[d0], qf[d0], s0); s1 = MFMA32(kc[d0], qf[d0], s1); }
            __builtin_amdgcn_s_setprio(0);
            ATT_SB();
            float mx;
            { float t0 = max3f(s0[0], s0[1], s0[2]), t1 = max3f(s0[3], s0[4], s0[5]), t2 = max3f(s0[6], s0[7], s0[8]), t3 = max3f(s0[9], s0[10], s0[11]), t4 = max3f(s0[12], s0[13], s0[14]);
              float u0 = max3f(s1[0], s1[1], s1[2]), u1 = max3f(s1[3], s1[4], s1[5]), u2 = max3f(s1[6], s1[7], s1[8]), u3 = max3f(s1[9], s1[10], s1[11]), u4 = max3f(s1[12], s1[13], s1[14]);
              t0 = max3f(t0, t1, t2); t3 = max3f(t3, t4, s0[15]); u0 = max3f(u0, u1, u2); u3 = max3f(u3, u4, s1[15]);
              mx = fmaxf(max3f(t0, t3, u0), u3); }
            mx = fmaxf(mx, __shfl_xor(mx, 32));
            if (__builtin_amdgcn_ballot_w64(!seen || mx > 8.f) != 0ull) {
                const float dl = seen ? fmaxf(mx, 0.f) : mx, al = seen ? __builtin_amdgcn_exp2f(-dl) : 0.f;
                mrun += dl; seen = true;
#pragma unroll
                for (int r = 0; r < 16; ++r) { s0[r] -= dl; s1[r] -= dl; negm[r] = -mrun; ol[r] *= al; }
#pragma unroll
                for (int d = 0; d < DVB; ++d)
#pragma unroll
                    for (int r = 0; r < 16; ++r) o[d][r] *= al;
            }
#pragma unroll
            for (int r = 0; r < 16; ++r) { s0[r] = __builtin_amdgcn_exp2f(s0[r]); s1[r] = __builtin_amdgcn_exp2f(s1[r]); }
#pragma unroll
            for (int j = 0; j < 4; ++j) { pw[0][j] = cvtpk(s0[2 * j], s0[2 * j + 1]); pw[1][j] = cvtpk(s0[8 + 2 * j], s0[8 + 2 * j + 1]);
                                          pw[2][j] = cvtpk(s1[2 * j], s1[2 * j + 1]); pw[3][j] = cvtpk(s1[8 + 2 * j], s1[8 + 2 * j + 1]); }
            ATT_SB();
            ATT_VREAD(vf, DH, DVB, vb_);
            ATT_SB();
            __builtin_amdgcn_s_setprio(1);
            ATT_PV2(vf, 0, DH);
#pragma unroll
            for (int ks = 0; ks < 4; ++ks) ol = MFMA32(ones, __builtin_bit_cast(bf16x8, pw[ks]), ol);
            ATT_PV2(vf, DH, DVB);
            __builtin_amdgcn_s_setprio(0);
        }
    }
    if (!NA) { const LAS unsigned char* vbp = lds + ((NT - 1) & (NS - 1)) * STAGE + KMAPS * KB + vlane;
        bf16x8 vfz[DVB][4]; ATT_VREAD(vfz, 0, DVB, vbp); ATT_PV2(vfz, 0, DVB);
#pragma unroll
        for (int ks = 0; ks < 4; ++ks) ol = MFMA32(ones, __builtin_bit_cast(bf16x8, pw[ks]), ol); }
    const float lrun = ol[0];
#undef ATT_VREAD
#undef ATT_PV2
#undef ATT_SB
#undef ATT_ISSUE
    ATT_WAITBAR(0);
    if (!SPLIT) {
        const float inv = 1.f / lrun;
        LAS unsigned char* stg = lds + 2 * STAGE + wid * (32 * DVB * 64);
#pragma unroll
        for (int d = 0; d < DVB; ++d)
#pragma unroll
            for (int i = 0; i < 4; ++i) { const int ch = d * 4 + i;
                v2u w; w.x = cvtpk(o[d][4 * i] * inv, o[d][4 * i + 1] * inv); w.y = cvtpk(o[d][4 * i + 2] * inv, o[d][4 * i + 3] * inv);
                *(LAS v2u*)(stg + r32 * (DVB * 64) + ((ch ^ (r32 & (DVB * 4 - 1))) * 16) + 8 * hi) = w; }
        constexpr int CPR = DVB * 4, RPP = 64 / CPR;
#pragma unroll
        for (int p = 0; p < 32 / RPP; ++p) { const int row = p * RPP + lane / CPR, ch = lane % CPR;
            const v4u y = *(const LAS v4u*)(stg + row * (DVB * 64) + ((ch ^ (row & (CPR - 1))) * 16));
            const size_t go = (size_t)ATT_QROW(row) * 1024 + vcol + ch * 8;
            const v4u z = *(const v4u*)(SZ + go);
            v4u w; w.x = cvtpk(bflo(y.x) * bflo(z.x), bfhi(y.x) * bfhi(z.x)); w.y = cvtpk(bflo(y.y) * bflo(z.y), bfhi(y.y) * bfhi(z.y));
            w.z = cvtpk(bflo(y.z) * bflo(z.z), bfhi(y.z) * bfhi(z.z)); w.w = cvtpk(bflo(y.w) * bflo(z.w), bfhi(y.w) * bfhi(z.w));
            *(v4u*)(YZ + go) = w; }
    } else {
        LAS float* ex = (LAS float*)lds + (wid & 3) * (DVB * 16 * 64) + lane;
        const float inv = (wmap ? lam : 1.f) / lrun;
        if (wmap) {
#pragma unroll
            for (int d = 0; d < DVB; ++d)
#pragma unroll
                for (int r = 0; r < 16; ++r) ex[(d * 16 + r) * 64] = o[d][r] * inv;
        }
        __syncthreads();
        if (!wmap) {
            float ss = 0.f;
#pragma unroll
            for (int d = 0; d < DVB; ++d)
#pragma unroll
                for (int r = 0; r < 16; ++r) { const float tv = o[d][r] * inv - ex[(d * 16 + r) * 64]; o[d][r] = tv; ss += tv * tv; }
            ss += __shfl_xor(ss, 32);
            const float rn = rsqrtf(ss * (1.f / (32.f * DVB)) + LN_EPS) * omli;
            LAS unsigned char* stg = lds + 2 * STAGE + (wid & 3) * (32 * DVB * 64);
#pragma unroll
            for (int d = 0; d < DVB; ++d)
#pragma unroll
                for (int i = 0; i < 4; ++i) { const int ch = d * 4 + i, dv0 = d * 32 + 8 * i + 4 * hi;
                    const f32x4 g4 = *(const f32x4*)(subg + dv0) * rn;
                    v2u w; w.x = cvtpk(o[d][4 * i] * g4[0], o[d][4 * i + 1] * g4[1]); w.y = cvtpk(o[d][4 * i + 2] * g4[2], o[d][4 * i + 3] * g4[3]);
                    *(LAS v2u*)(stg + r32 * (DVB * 64) + ((ch ^ (r32 & (DVB * 4 - 1))) * 16) + 8 * hi) = w; }
            constexpr int CPR = DVB * 4, RPP = 64 / CPR;
#pragma unroll
            for (int p = 0; p < 32 / RPP; ++p) { const int row = p * RPP + lane / CPR, ch = lane % CPR;
                const v4u y = *(const LAS v4u*)(stg + row * (DVB * 64) + ((ch ^ (row & (CPR - 1))) * 16));
                const size_t go = (size_t)ATT_QROW(row) * 1024 + vcol + ch * 8;
                const v4u z = *(const v4u*)(SZ + go);
                v4u w; w.x = cvtpk(bflo(y.x) * bflo(z.x), bfhi(y.x) * bfhi(z.x)); w.y = cvtpk(bflo(y.y) * bflo(z.y), bfhi(y.y) * bfhi(z.y));
                w.z = cvtpk(bflo(y.z) * bflo(z.z), bfhi(y.z) * bfhi(z.z)); w.w = cvtpk(bflo(y.w) * bflo(z.w), bfhi(y.w) * bfhi(z.w));
                *(v4u*)(YZ + go) = w; }
        }
        __syncthreads();
    }
}

#define XB_TMO      128
#define XB_XCNT(j)  (256  + 64 * (j))
#define XB_XSUB(j)  (1280 + 64 * (j))
#define XB_XGEN(j)  (2304 + 64 * (j))
#define XB_TOP      3328
#define XB_TOPGEN   3392
#define XCD_BAR_WORDS 3456
#define XB_SPIN_CAP (1u << 18)

__device__ __forceinline__ unsigned xb_ld(unsigned* p)              { return __hip_atomic_load(p, __ATOMIC_RELAXED, __HIP_MEMORY_SCOPE_AGENT); }
__device__ __forceinline__ unsigned xb_add(unsigned* p, unsigned v) { return __hip_atomic_fetch_add(p, v, __ATOMIC_RELAXED, __HIP_MEMORY_SCOPE_AGENT); }
__device__ __forceinline__ unsigned xb_xcc_id() { return (unsigned)__builtin_amdgcn_s_getreg((3 << 11) | 20) & 0xFu; }
#define XB_SPIN(cond, bar) do { unsigned _sp = 0; while (cond) { __builtin_amdgcn_s_sleep(1); \
    if ((++_sp & 255u) == 0u) { if (xb_ld(&(bar)[XB_TMO])) break; if (_sp > XB_SPIN_CAP) { atomicAdd(&(bar)[XB_TMO], 1u); break; } } } } while (0)

struct XcdBarrier {
    unsigned* bar; unsigned x;
    volatile LAS unsigned* st;
};

__device__ __forceinline__ XcdBarrier xcd_barrier_post(unsigned* bar, volatile LAS unsigned* st) {
    XcdBarrier b; b.bar = bar; b.x = xb_xcc_id(); b.st = st;
    if (threadIdx.x == 0) (void)xb_add(&bar[XB_XCNT(b.x)], 1u);
    return b;
}
__device__ __forceinline__ void xcd_barrier_complete(unsigned* bar, unsigned x, unsigned& nloc, unsigned& nx) {
    const unsigned G = gridDim.x * gridDim.y * gridDim.z;
    unsigned sum, cnt, mine, sp = 0u;
    for (;;) {
        sum = 0u; cnt = 0u; mine = 0u;
#pragma unroll
        for (unsigned j = 0; j < 16; ++j) { const unsigned c = xb_ld(&bar[XB_XCNT(j)]); sum += c; cnt += (c > 0u) ? 1u : 0u; mine = (j == x) ? c : mine; }
        if (sum == G) break;
        __builtin_amdgcn_s_sleep(1);
        if ((++sp & 255u) == 0u) { if (xb_ld(&bar[XB_TMO])) break; if (sp > XB_SPIN_CAP) { atomicAdd(&bar[XB_TMO], 1u); break; } }
    }
    nloc = mine > 0u ? mine : 1u; nx = cnt > 0u ? cnt : 1u;
}

__device__ __forceinline__ void xcd_barrier(const XcdBarrier& b) {
    asm volatile("s_waitcnt vmcnt(0)" ::: "memory");
    __syncthreads();
    if (threadIdx.x == 0) {
        unsigned* bar = b.bar;
        __builtin_amdgcn_s_waitcnt(0);
        unsigned nloc = b.st[0], nx = b.st[1];
        if (nloc == 0u) { xcd_barrier_complete(bar, b.x, nloc, nx); b.st[0] = nloc; b.st[1] = nx; }
        const unsigned old = xb_add(&bar[XB_XSUB(b.x)], 1u);
        const unsigned gen = old / nloc;
        if (old + 1u == (gen + 1u) * nloc) {
            __builtin_amdgcn_fence(__ATOMIC_RELEASE, "agent");
            asm volatile("s_waitcnt vmcnt(0)" ::: "memory");
            const unsigned og = xb_add(&bar[XB_TOP], 1u);
            const unsigned tg = og / nx;
            if (og + 1u == (tg + 1u) * nx) xb_add(&bar[XB_TOPGEN], 1u);
            else XB_SPIN(xb_ld(&bar[XB_TOPGEN]) == tg, bar);
            __builtin_amdgcn_fence(__ATOMIC_ACQUIRE, "agent");
            xb_add(&bar[XB_XGEN(b.x)], 1u);
            asm volatile("s_waitcnt vmcnt(0)" ::: "memory");
        } else {
            XB_SPIN(xb_ld(&bar[XB_XGEN(b.x)]) == gen, bar);
            __builtin_amdgcn_fence(__ATOMIC_ACQUIRE, "agent");
            asm volatile("s_waitcnt vmcnt(0)" ::: "memory");
        }
    }
    __syncthreads();
}
__device__ __forceinline__ void p0_transpose_item(const float* W, int K, int N, bf16* WT, int row_off, LAS float* scr, int item, int lane) {
    const int nblk = N / 32, kb = item / nblk, nb = item % nblk, k0 = 64 * kb, n0 = 32 * nb;
    float wv[32];
#pragma unroll
    for (int i = 0; i < 32; ++i) { const int kk = 2 * i + (lane >> 5); wv[i] = W[(size_t)(k0 + kk) * N + n0 + (lane & 31)]; }
#pragma unroll
    for (int i = 0; i < 32; ++i) { const int kk = 2 * i + (lane >> 5); scr[kk * 33 + (lane & 31)] = wv[i]; }
    LDS_WAIT(); asm volatile("" ::: "memory");
    const int c = lane & 7;
#pragma unroll
    for (int j = 0; j < 4; ++j) { const int n = (lane >> 3) + 8 * j; const LAS float* s = scr + (8 * c) * 33 + n;
        v4u o; o.x = pk2(s[0 * 33], s[1 * 33]); o.y = pk2(s[2 * 33], s[3 * 33]); o.z = pk2(s[4 * 33], s[5 * 33]); o.w = pk2(s[6 * 33], s[7 * 33]);
        *(GAS v4u*)(WT + (size_t)(row_off + n0 + n) * K + k0 + 8 * c) = o; }
    LDS_WAIT(); asm volatile("" ::: "memory");
}

__device__ __forceinline__ void sincos_d(double x, double& s, double& c) {
    const double n = __builtin_rint(x * 0.63661977236758134308);
    const double r = (x - n * 1.57079632679489655800) - n * 6.12323399573676603587e-17;
    const double r2 = r * r;
    double sp = -7.6471637318198164759e-13; sp = sp * r2 + 1.6059043836821614599e-10; sp = sp * r2 - 2.5052108385441718775e-08; sp = sp * r2 + 2.7557319223985890653e-06;
    sp = sp * r2 - 1.9841269841269841270e-04; sp = sp * r2 + 8.3333333333333333333e-03; sp = sp * r2 - 1.6666666666666666667e-01; sp = r + r * r2 * sp;
    double cp = 4.7794773323873852974e-14; cp = cp * r2 - 1.1470745597729724714e-11; cp = cp * r2 + 2.0876756987868098979e-09; cp = cp * r2 - 2.7557319223985890653e-07;
    cp = cp * r2 + 2.4801587301587301587e-05; cp = cp * r2 - 1.3888888888888888889e-03; cp = cp * r2 + 4.1666666666666666667e-02; cp = cp * r2 - 0.5; cp = 1.0 + r2 * cp;
    const int q = ((int)n) & 3;
    s = (q == 0) ? sp : (q == 1) ? cp : (q == 2) ? -sp : -cp;
    c = (q == 0) ? cp : (q == 1) ? -sp : (q == 2) ? -cp : sp;
}

struct OneUnit { int pm, pn;
    __device__ __forceinline__ bool next(int i, pg8::Unit& u) const { if (i) return false; u.pm = pm; u.pn = pn; return true; }
    __device__ __forceinline__ void a_ready(const pg8::Unit&) const {}
    __device__ __forceinline__ void done(const pg8::Unit&) const {} };
__device__ __forceinline__ void sub_barrier(unsigned* ctr, unsigned target, int tid) {
    asm volatile("s_waitcnt vmcnt(0)" ::: "memory"); __syncthreads();
    if (tid == 0) {
        __builtin_amdgcn_fence(__ATOMIC_RELEASE, "agent"); asm volatile("s_waitcnt vmcnt(0)" ::: "memory");
        __hip_atomic_fetch_add(ctr, 1u, __ATOMIC_RELAXED, __HIP_MEMORY_SCOPE_AGENT);
        unsigned sp = 0;
        while (__hip_atomic_load(ctr, __ATOMIC_RELAXED, __HIP_MEMORY_SCOPE_AGENT) < target) { __builtin_amdgcn_s_sleep(2); if (++sp > (1u << 22)) break; }
        __builtin_amdgcn_fence(__ATOMIC_ACQUIRE, "agent"); asm volatile("s_waitcnt vmcnt(0)" ::: "memory");
    }
    __syncthreads();
}
constexpr int NCW = 32;
struct Args { const float* in[13]; float* out; unsigned char* ws; int ph_lo, ph_hi; };

__global__ void __launch_bounds__(NWAVES * 64, 2) fwd_kernel(Args args) {
    extern __shared__ __attribute__((aligned(16))) unsigned char lds_raw[];
    LAS unsigned char* lds = (LAS unsigned char*)lds_raw;
    cg::grid_group grid = cg::this_grid();
    const int tid0 = threadIdx.x, wave = __builtin_amdgcn_readfirstlane(tid0 >> 6);
#define OPAQUE_TID() int tid = wave * 64 + lane_id_v(); asm volatile("" : "+v"(tid)); const int lane = tid & 63
    const int G = gridDim.x, bx = blockIdx.x;
    const int vcu = (G % 8 == 0) ? (bx % 8) * (G / 8) + bx / 8 : bx;
    const int gw = vcu * NWAVES + wave, NGW = G * NWAVES;
    unsigned char* ws = args.ws;
    const float* x_in = args.in[0]; const float* c_in = args.in[1]; const float* ctx_in = args.in[2]; const float* cctx_in = args.in[3];
    const float* w_mod = args.in[4]; const float* b_mod = args.in[5]; const float* w_in = args.in[6]; const float* w_out = args.in[7];
    const float* ln_g = args.in[8]; const float* ln_b = args.in[9]; const float* na_rpb = args.in[10]; const float* diff_lambda = args.in[11]; const float* diff_subln = args.in[12];
    float* statsB = (float*)(ws + WS_STATS); float* modT = (float*)(ws + WS_MOD); float* cosT = (float*)(ws + WS_COS); float* sinT = (float*)(ws + WS_SIN);
    bf16* Win_t = (bf16*)(ws + WS_WIN); bf16* Wout_t = (bf16*)(ws + WS_WOUT);
    float* XRx = args.out; float* XRc = (float*)(ws + WS_XRC);
    bf16* XN = (bf16*)(ws + WS_XN); bf16* Qb = (bf16*)(ws + WS_Q); bf16* Kb = (bf16*)(ws + WS_K); bf16* Vb = (bf16*)(ws + WS_V); bf16* Zb = (bf16*)(ws + WS_Z); bf16* YZ = (bf16*)(ws + WS_YZ);
    const int lo = args.ph_lo, hi_ph = args.ph_hi;
    volatile LAS unsigned* MISC = (volatile LAS unsigned*)(lds + LDS_BYTES - 256);
    if (tid0 < 64) MISC[tid0] = 0u;
    __syncthreads();
    XcdBarrier bar = xcd_barrier_post((unsigned*)(args.ws + WS_CTL) + CW_BAR, MISC + 8);
#define IN_PH(k) (lo <= (k) && (k) < hi_ph)
#define SEAM(k) do { if (lo <= (k) && (k) + 1 < hi_ph) xcd_barrier(bar); } while (0)
    if (lo < 0) grid.sync();

    if (IN_PH(0)) for (int rep0_ = 0; rep0_ < REP_P0; ++rep0_) {
        OPAQUE_TID();
        if (rep0_) __syncthreads();
        LAS float* scr = (LAS float*)(lds + wave * 16384);
        constexpr int PER_L = 2048 + 512, NIT = DEPTH * PER_L;
        for (int it = gw; it < NIT; it += NGW) {
            const int l = it / PER_L, r = it % PER_L;
            if (r < 2048) p0_transpose_item(w_in + (size_t)l * 1024 * 4096, 1024, 4096, Win_t + (size_t)l * 4096 * 1024, 0, scr, r, lane);
            else p0_transpose_item(w_out + (size_t)l * 1024 * 1024, 1024, 1024, Wout_t + (size_t)l * 1024 * 1024, 0, scr, r - 2048, lane);
        }
        { const int gt = bx * (NWAVES * 64) + tid;
          if (gt < 1024) { const float invf[16] = {1.0f, 0.5623413324356079f, 0.3162277638912201f, 0.17782793939113617f, 0.10000000149011612f, 0.05623413249850273f, 0.03162277489900589f, 0.017782794311642647f,
                                                   0.009999999776482582f, 0.005623413249850273f, 0.003162277629598975f, 0.0017782794311642647f, 0.0010000000474974513f, 0.000562341301701963f, 0.0003162277571391314f, 0.00017782794020604342f};
              const int pos = gt >> 4, f = gt & 15; float fv = invf[0];
#pragma unroll
              for (int q = 1; q < 16; ++q) fv = (f == q) ? invf[q] : fv;
              const float ang = (float)pos * fv; double s, c; sincos_d((double)ang, s, c); cosT[gt] = (float)c; sinT[gt] = (float)s; } }
        __syncthreads();
        LAS float* sil = (LAS float*)lds;
        LAS float* red = sil + 9 * 1024;
        for (int i = tid; i < 9 * 1024; i += NWAVES * 64) { const int j = i >> 10, k = i & 1023; const float cv = j < 8 ? c_in[j * 1024 + k] : cctx_in[k]; sil[i] = cv / (1.f + expf(-cv)); }
        __syncthreads();
        for (int item = bx; item < DEPTH * 48; item += G) {
            const int l = item / 48, cb = item % 48;
            const float* W = w_mod + (size_t)l * 1024 * 3072 + cb * 64 + lane;
            float a0 = 0.f, a1 = 0.f, a2 = 0.f, a3 = 0.f, a4 = 0.f, a5 = 0.f, a6 = 0.f, a7 = 0.f, a8 = 0.f;
#pragma unroll 32
            for (int kk = 0; kk < 128; ++kk) { const int k = wave * 128 + kk; const float wv = W[(size_t)k * 3072];
                a0 += sil[k] * wv; a1 += sil[1024 + k] * wv; a2 += sil[2048 + k] * wv; a3 += sil[3072 + k] * wv; a4 += sil[4096 + k] * wv;
                a5 += sil[5120 + k] * wv; a6 += sil[6144 + k] * wv; a7 += sil[7168 + k] * wv; a8 += sil[8192 + k] * wv; }
            LAS float* rw = red + wave * 9 * 64 + lane;
            rw[0] = a0; rw[64] = a1; rw[128] = a2; rw[192] = a3; rw[256] = a4; rw[320] = a5; rw[384] = a6; rw[448] = a7; rw[512] = a8;
            __syncthreads();
            for (int i = tid; i < 9 * 64; i += NWAVES * 64) { const int j = i >> 6, cc = i & 63; float s = b_mod[l * 3072 + cb * 64 + cc];
#pragma unroll
                for (int w = 0; w < 8; ++w) s += red[(w * 9 + j) * 64 + cc];
                modT[(size_t)(l * 9 + j) * 3072 + cb * 64 + cc] = s; }
            __syncthreads();
        }
    }
    SEAM(0);

    for (int l = 0; l < DEPTH; ++l) {
        const bool need_ctx = l < DEPTH - 1;
        if (IN_PH(1 + 4 * l)) for (int repa_ = 0; repa_ < REP_A; ++repa_) {
            OPAQUE_TID(); const float* modl = modT + (size_t)l * 9 * 3072;
            const bool side = (l > 0) && (G > 2 * NCW);
            int row_lo = gw, row_hi = MT, row_st = NGW;
            if (side) {
                if (bx < NCW) {
                    const int lp = l - 1; const float* modp = modT + (size_t)lp * 9 * 3072;
                    pg8::Gemm g{YZ, Wout_t + (size_t)lp * 1024 * 1024, MT, 1024, 1024}; OneUnit S{MX / 256 + (bx >> 2), bx & 3};
                    pg8::EpiOut E{lp == 0 ? x_in : XRx, lp == 0 ? ctx_in : XRc, XRx, XRc, modp, lp == 0 ? nullptr : statsB, ln_g + (lp - 1) * 1024, ln_b + (lp - 1) * 1024};
                    pg8::gemm_phase<pg8::EpiOut, OneUnit, true, true>(lds, g, S, E, wave);
                    sub_barrier((unsigned*)(ws + WS_CTL) + CW_SUB, (unsigned)(NCW * l), tid);
                    row_lo = MX + bx * NWAVES + wave; row_hi = MT; row_st = NCW * NWAVES;
                } else { row_lo = (bx - NCW) * NWAVES + wave; row_hi = MX; row_st = (G - NCW) * NWAVES; }
            }
            constexpr int RB = 4;
            for (int row0 = row_lo; row0 < row_hi; row0 += RB * row_st) {
                f32x4 v[RB][4];
#pragma unroll
                for (int u = 0; u < RB; ++u) { const int row = row0 + u * row_st; const int rowc = row < row_hi ? row : row0;
                    const bool isc = rowc >= MX; const int rr = isc ? rowc - MX : rowc;
                    const float* src = (l == 0) ? (isc ? ctx_in : x_in) : (isc ? XRc : XRx);
                    const GAS f32x4* xr = (const GAS f32x4*)(src + (size_t)rr * 1024) + lane;
#pragma unroll
                    for (int j = 0; j < 4; ++j) v[u][j] = xr[64 * j]; }
#pragma unroll
                for (int u = 0; u < RB; ++u) { const int row = row0 + u * row_st; if (row >= row_hi) break;
                    const bool isc = row >= MX;
                    if (l > 0) {
                        float s = 0.f;
#pragma unroll
                        for (int j = 0; j < 4; ++j) s += (v[u][j].x + v[u][j].y) + (v[u][j].z + v[u][j].w);
                        const float mean = wave_sum(s) * (1.f / 1024.f); float s2 = 0.f;
#pragma unroll
                        for (int j = 0; j < 4; ++j) { v[u][j] = v[u][j] - mean; s2 += (v[u][j].x * v[u][j].x + v[u][j].y * v[u][j].y) + (v[u][j].z * v[u][j].z + v[u][j].w * v[u][j].w); }
                        const float rstd = 1.f / sqrtf(wave_sum(s2) * (1.f / 1024.f) + LN_EPS);
                        if (lane == 0) { float* sp = statsB + 2 * (size_t)row; sp[0] = mean; sp[1] = rstd; }
#pragma unroll
                        for (int j = 0; j < 4; ++j) { const f32x4 g4 = *((const f32x4*)(ln_g + (l - 1) * 1024) + lane + 64 * j), b4 = *((const f32x4*)(ln_b + (l - 1) * 1024) + lane + 64 * j);
                            v[u][j] = v[u][j] * rstd * g4 + b4; }
                    }
                    const float* mrow = modl + (isc ? 8 : (row >> 12)) * 3072;
                    GAS v2u* o8 = (GAS v2u*)(XN + (size_t)row * 1024) + lane;
#pragma unroll
                    for (int j = 0; j < 4; ++j) { const f32x4 sh = *((const f32x4*)mrow + lane + 64 * j), sc = *((const f32x4*)(mrow + 1024) + lane + 64 * j);
                        const f32x4 h = v[u][j] * (sc + 1.f) + sh; v2u w; w.x = cvtpk(h.x, h.y); w.y = cvtpk(h.z, h.w); o8[64 * j] = w; }
                }
            }
        }
        SEAM(1 + 4 * l);
        if (IN_PH(2 + 4 * l)) for (int rep_ = 0; rep_ < REP_B; ++rep_) {
            pg8::Gemm g{XN, Win_t + (size_t)l * 4096 * 1024, MT, 4096, 1024}; pg8::StaticOrder S; S.init(MT, 4096, G, bx);
            pg8::EpiIn E{Qb, ACT / 2, l & 1, cosT, sinT};
            pg8::gemm_phase<pg8::EpiIn, pg8::StaticOrder, true, true>(lds, g, S, E, wave);
        }
        SEAM(2 + 4 * l);
        if (IN_PH(3 + 4 * l)) {
            OPAQUE_TID();
#ifndef NO_NA
            if ((l & 1) == 0) for (int rep_ = 0; rep_ < REP_NA; ++rep_) {
                LAS float* rpbL = (LAS float*)(lds + NAB_RPB);
                const float* rpb = na_rpb + (size_t)(l >> 1) * 16 * 15 * 31;
                constexpr int NXU = NB * 16 * 16; const int per = (NXU + G - 1) / G;
                int hl = -1;
                const bool xl = (G == 256);
                for (int i = 0; i < per; ++i) { const int u = vcu * per + i; if (u >= NXU) break;
                    const int bh = xl ? (i * 16 + 2 * (vcu >> 5) + ((vcu >> 4) & 1)) : (u >> 4), rq = xl ? (vcu & 15) : (u & 15), b = bh >> 4, h = bh & 15, rlo = 4 * rq;
                    const int kr0 = clampi(rlo - 4, 0, 56), n1 = clampi(rlo - 1, 0, 56) + 8 - kr0;
                    if (h != hl) {
                        for (int q = tid; q < 15 * 31; q += NWAVES * 64) rpbL[q] = rpb[h * 465 + q] * LOG2E;
                        __syncthreads();
                        LAS float* tint = (LAS float*)(lds + NAB_TINT); LAS float* tb = (LAS float*)(lds + NAB_TB);
                        for (int q = tid; q < 16 * 128; q += NWAVES * 64) { const int tr = q >> 7, dc = (q & 127) - 48; tint[q] = (tr >= 1 && dc >= 7 && dc <= 22) ? rpbL[(tr - 1) * 31 + dc] : -1e30f; }
                        for (int q = tid; q < 15 * 16 * 64; q += NWAVES * 64) { const int v = q >> 10, rem = q & 1023, tr = rem >> 6, kc = rem & 63, w = v < 8 ? v : v + 49;
                            const int c0 = clampi(w - 8, 0, 48), dc = kc - w + 15; tb[q] = (tr >= 1 && kc >= c0 && kc <= c0 + 15) ? rpbL[(tr - 1) * 31 + dc] : -1e30f; }
                        hl = h; }
                    attn_unit<2, true, false>((PROBE_NA && rep_ == 0) ? PROBE_NA : 0, wave, lds, Qb, Kb, Vb, Zb, (PROBE_NA && rep_ == 0) ? XN : YZ, b * SEQ + rlo * 64, h * 64, h * 64, b * SEQ + kr0 * 64, n1, MX + b * CTXL, 4, kr0, true, rlo, rpbL, 0.f, 0.f, nullptr);
                }
                if (need_ctx) for (int u = vcu; u < NB * 16; u += G) { const int b = u >> 4, h = u & 15;
                    attn_unit<2, true, false>(0, wave, lds, Qb, Kb, Vb, Zb, YZ, MX + b * CTXL, h * 64, h * 64, 0, 0, MX + b * CTXL, 4, 0, false, 0, rpbL, 0.f, 0.f, nullptr); }
            }
#endif
#ifndef NO_DIFF
            if ((l & 1) == 1) for (int rep_ = 0; rep_ < REP_DIFF; ++rep_) {
                const float li = (l == 1) ? 0.35550906759096934f : 0.5560582041556406f;
                const float* lp = diff_lambda + (size_t)(l >> 1) * 256;
                const float sa = wave_sum(lp[lane] * lp[64 + lane]), sb = wave_sum(lp[128 + lane] * lp[192 + lane]);
                const float lam = expf(sa) - expf(sb) + li;
                const float* subg = diff_subln + (size_t)(l >> 1) * 128;
                constexpr int NXU = NB * 8 * 32; const int per = (NXU + G - 1) / G;
                const bool xl = (G == 256);
                for (int i = 0; i < per; ++i) { const int u = vcu * per + i; if (u >= NXU) break;
                    const int bh = xl ? ((vcu >> 5) * 8 + i) : (u >> 5), qb = xl ? (vcu & 31) : (u & 31), b = bh >> 3, h = bh & 7;
                    attn_unit<4, false, true>((PROBE_DIFF && rep_ == 0) ? PROBE_DIFF : 0, wave, lds, Qb, Kb, Vb, Zb, (PROBE_DIFF && rep_ == 0) ? XN : YZ, b * SEQ + qb * 128, h * 128, h * 128, b * SEQ, 64, MX + b * CTXL, 4, 0, true, 0, nullptr, lam, 1.f - li, subg);
                }
                if (need_ctx) for (int u = vcu; u < NB * 8 * 2; u += G) { const int b = u >> 4, h = (u >> 1) & 7, qh = u & 1;
                    attn_unit<4, false, true>(0, wave, lds, Qb, Kb, Vb, Zb, YZ, MX + b * CTXL + qh * 128, h * 128, h * 128, 0, 0, MX + b * CTXL, 4, 0, false, 0, nullptr, lam, 1.f - li, subg); }
            }
#endif
        }
        SEAM(3 + 4 * l);
        if (IN_PH(4 + 4 * l)) {
            const float* modl = modT + (size_t)l * 9 * 3072;
            const int Mo = (need_ctx && !(G > 2 * NCW)) ? MT : MX;
            pg8::Gemm g{YZ, Wout_t + (size_t)l * 1024 * 1024, Mo, 1024, 1024}; pg8::StaticOrder S; S.init(Mo, 1024, G, bx);
            for (int repd_ = 0; repd_ < REP_D; ++repd_) {
            pg8::EpiOut E{l == 0 ? x_in : XRx, l == 0 ? ctx_in : XRc, (repd_ + 1 < REP_D) ? (float*)Qb : XRx, XRc, modl, l == 0 ? nullptr : statsB, ln_g + (l - 1) * 1024, ln_b + (l - 1) * 1024};
            pg8::gemm_phase<pg8::EpiOut, pg8::StaticOrder, true, true>(lds, g, S, E, wave);
            }
        }
        SEAM(4 + 4 * l);
    }
    if (IN_PH(NPH - 1)) {
        OPAQUE_TID();
        constexpr int RB = 4;
        for (int row0 = gw; row0 < MX; row0 += RB * NGW) {
            f32x4 v[RB][4];
#pragma unroll
            for (int u = 0; u < RB; ++u) { const int row = row0 + u * NGW; const int rowc = row < MX ? row : row0;
                const GAS f32x4* xr = (const GAS f32x4*)(XRx + (size_t)rowc * 1024) + lane;
#pragma unroll
                for (int j = 0; j < 4; ++j) v[u][j] = __builtin_nontemporal_load(xr + 64 * j); }
#pragma unroll
            for (int u = 0; u < RB; ++u) { const int row = row0 + u * NGW; if (row >= MX) break;
                GAS f32x4* xo = (GAS f32x4*)(XRx + (size_t)row * 1024) + lane;
                float s = 0.f;
#pragma unroll
                for (int j = 0; j < 4; ++j) s += (v[u][j].x + v[u][j].y) + (v[u][j].z + v[u][j].w);
                const float mean = wave_sum(s) * (1.f / 1024.f); float s2 = 0.f;
#pragma unroll
                for (int j = 0; j < 4; ++j) { v[u][j] = v[u][j] - mean; s2 += (v[u][j].x * v[u][j].x + v[u][j].y * v[u][j].y) + (v[u][j].z * v[u][j].z + v[u][j].w * v[u][j].w); }
                const float rstd = 1.f / sqrtf(wave_sum(s2) * (1.f / 1024.f) + LN_EPS);
#pragma unroll
                for (int j = 0; j < 4; ++j) { const f32x4 g4 = *((const f32x4*)(ln_g + 3 * 1024) + lane + 64 * j), b4 = *((const f32x4*)(ln_b + 3 * 1024) + lane + 64 * j);
                    __builtin_nontemporal_store(v[u][j] * rstd * g4 + b4, xo + 64 * j); }
            }
        }
    }
#undef IN_PH
#undef SEAM
}

#ifndef N_LAUNCH_MODE_GUARD_DUMMY
#endif
#ifndef N_LAUNCH_MODE
#define N_LAUNCH_MODE 1
#endif
extern "C" void kernel_launch(void* const* d_in, const int* in_sizes, int n_in, void* d_out, int out_size, void* d_ws, size_t ws_size, hipStream_t stream) {
    static int grid = 0;
    if (grid == 0) {
        if (n_in != 13 || out_size != MX * DM || ws_size < WS_END) { fprintf(stderr, "kernel_launch: unexpected shapes (n_in %d out %d ws %zu)\n", n_in, out_size, ws_size); grid = -1; return; }
        int dev = 0, cus = 0, per_cu = 0;
        hipGetDevice(&dev); hipDeviceGetAttribute(&cus, hipDeviceAttributeMultiprocessorCount, dev);
        if (hipFuncSetAttribute((const void*)fwd_kernel, hipFuncAttributeMaxDynamicSharedMemorySize, LDS_BYTES) != hipSuccess) { fprintf(stderr, "kernel_launch: hipFuncSetAttribute failed\n"); grid = -1; return; }
        if (hipOccupancyMaxActiveBlocksPerMultiprocessor(&per_cu, (const void*)fwd_kernel, NWAVES * 64, LDS_BYTES) != hipSuccess || per_cu < 1) { fprintf(stderr, "kernel_launch: occupancy query gave %d\n", per_cu); per_cu = 1; }
        (void)hipGetLastError();
        grid = cus * 1;
        if (grid <= 0) grid = 256;
    }
    if (grid < 0) return;
    if (hipMemsetAsync((char*)d_ws + WS_CTL, 0, CTL_ZERO_BYTES, stream) != hipSuccess) { fprintf(stderr, "kernel_launch: hipMemsetAsync failed\n"); return; }
    Args a{};
    for (int i = 0; i < 13; ++i) a.in[i] = (const float*)d_in[i];
    a.out = (float*)d_out; a.ws = (unsigned char*)d_ws;
#if N_LAUNCH_MODE == 1
    a.ph_lo = 0; a.ph_hi = NPH;
    void* kargs[] = {&a};
    hipError_t e = hipLaunchCooperativeKernel((const void*)fwd_kernel, dim3(grid), dim3(NWAVES * 64), kargs, LDS_BYTES, stream);
    if (e != hipSuccess) fprintf(stderr, "cooperative launch failed: %s (grid %d)\n", hipGetErrorString(e), grid);
#else
    for (int p = 0; p < NPH; ++p) { a.ph_lo = p; a.ph_hi = p + 1; hipLaunchKernelGGL(fwd_kernel, dim3(grid), dim3(NWAVES * 64), LDS_BYTES, stream, a); }
#endif
}
```
